# Optimizing an MI355X kernel written in HIP

```python
import math
import jax
import jax.numpy as jnp
from jax import lax
import numpy as np

D_MODEL = 1024
BATCH = 16
SEQ = 2048
DEPTH = 1

MEM_LEN = 256
MIX_WIDTH = 2 * D_MODEL
SSD_WIDTH = MIX_WIDTH // 2
SSD_HEAD_DIM = 64
SSD_HEADS = SSD_WIDTH // SSD_HEAD_DIM
SSD_STATE = 128
SSD_GROUPS = 4
SSD_CONV = 5
SSD_CHUNK = 128
DT_MIN = 0.001
DT_MAX = 0.1
ATT_WIDTH = MIX_WIDTH - SSD_WIDTH
ATT_HEAD_DIM = 64
ATT_HEADS = ATT_WIDTH // ATT_HEAD_DIM
DILATED_PATTERNS = ((128, 1), (512, 4), (2048, 16))
WIN_BLOCK = 64
MEM_HEADS = 4
MEM_WIDTH = D_MODEL
MEM_HEAD_DIM = MEM_WIDTH // MEM_HEADS
N_EXPERTS = 256
ROUTE_GROUPS = 8
TOPK_GROUPS = 4
TOP_K = 8
EXPERT_DIM = 256
SHARED_DIM = 256
ROUTED_SCALE = 2.5
MOE_BLOCK = 256
DN_ALPHA = (2.0 * DEPTH) ** 0.25
DN_BETA = (8.0 * DEPTH) ** -0.25
LN_EPS = 1e-5
RMS_EPS = 1e-5
NEG_INF = -1e30
GN = SSD_GROUPS * SSD_STATE
CONV_CH = SSD_WIDTH + 2 * GN
Z_OFF = 0
XBC_OFF = Z_OFF + SSD_WIDTH
DT_OFF = XBC_OFF + CONV_CH
Q_OFF = DT_OFF + 2 * SSD_HEADS
K_OFF = Q_OFF + ATT_WIDTH
V_OFF = K_OFF + ATT_WIDTH
IN_COLS = V_OFF + ATT_WIDTH

kernel_name = 'hybrid_ssd_dilated_moe_encoder_layer'


def _layer_norm(x, g, b):
    xf = x.astype(jnp.float32)
    mu = jnp.mean(xf, -1, keepdims=True)
    var = jnp.mean(jnp.square(xf - mu), -1, keepdims=True)
    return ((xf - mu) * lax.rsqrt(var + LN_EPS) * g + b).astype(x.dtype)


def _rms_norm(y, w):
    y = y.astype(jnp.float32)
    return y * lax.rsqrt(jnp.mean(jnp.square(y), -1, keepdims=True) + RMS_EPS) * w


def _alibi_slopes():
    return np.array([2.0 ** (-8.0 * (h + 1) / ATT_HEADS) for h in range(ATT_HEADS)], dtype=np.float32)


def _centred_depthwise_conv(u, w, b):
    c = u.shape[-1]
    y = lax.conv_general_dilated(u, w.astype(u.dtype)[:, None, :], window_strides=(1,),
                                 padding=[(SSD_CONV // 2, SSD_CONV // 2)],
                                 dimension_numbers=('NWC', 'WIO', 'NWC'), feature_group_count=c)
    return y + b.astype(u.dtype)


def _ssd_scan(xh, dt, a, bm, cm):
    bsz, s, h, p = xh.shape
    g, n = bm.shape[2], bm.shape[3]
    r = h // g
    q = SSD_CHUNK
    c = s // q
    x = (xh * dt[..., None]).reshape(bsz, c, q, g, r, p)
    cs = jnp.cumsum((dt * a).reshape(bsz, c, q, g, r), axis=2)
    bmc = bm.reshape(bsz, c, q, g, n)
    cmc = cm.reshape(bsz, c, q, g, n)
    seg = cs[:, :, :, None] - cs[:, :, None, :]
    mask = jnp.tril(jnp.ones((q, q), dtype=bool))[:, :, None, None]
    decay = jnp.exp(jnp.where(mask, seg, NEG_INF))
    cb = jnp.einsum('bcqgn,bckgn->bcqkg', cmc, bmc)
    y_diag = jnp.einsum('bcqkg,bcqkgr,bckgrp->bcqgrp', cb, decay, x)
    decay_s = jnp.exp(cs[:, :, -1:] - cs)
    states = jnp.einsum('bckgn,bckgr,bckgrp->bcgrpn', bmc, decay_s, x)
    chunk_decay = jnp.exp(cs[:, :, -1])

    def step(hs, inp):
        st, dec = inp
        return hs * dec[..., None, None] + st, hs

    h0 = jnp.zeros((bsz, g, r, p, n), jnp.float32)
    _, prev = lax.scan(step, h0, (jnp.moveaxis(states, 1, 0), jnp.moveaxis(chunk_decay, 1, 0)))
    prev = jnp.moveaxis(prev, 0, 1)
    y_off = jnp.einsum('bcqgn,bcgrpn,bcqgr->bcqgrp', cmc, prev, jnp.exp(cs))
    return (y_diag + y_off).reshape(bsz, s, h, p)


def _ssd_group(z, xbc, dt_raw, conv_w, conv_b, dt_bias_f, dt_bias_b, a_log_f, a_log_b, d_skip, norm_w):
    bsz, s, _ = z.shape
    xbc = jax.nn.silu(_centred_depthwise_conv(xbc, conv_w, conv_b)).astype(jnp.float32)
    xh = xbc[..., :SSD_WIDTH].reshape(bsz, s, SSD_HEADS, SSD_HEAD_DIM)
    bm = xbc[..., SSD_WIDTH:SSD_WIDTH + GN].reshape(bsz, s, SSD_GROUPS, SSD_STATE)
    cm = xbc[..., SSD_WIDTH + GN:].reshape(bsz, s, SSD_GROUPS, SSD_STATE)
    dt_raw = dt_raw.astype(jnp.float32)
    dt_f = jax.nn.softplus(dt_raw[..., :SSD_HEADS] + dt_bias_f.astype(jnp.float32))
    dt_b = jax.nn.softplus(dt_raw[..., SSD_HEADS:] + dt_bias_b.astype(jnp.float32))
    a_f = -jnp.exp(a_log_f.astype(jnp.float32))
    a_b = -jnp.exp(a_log_b.astype(jnp.float32))
    flip = lambda t: jnp.flip(t, axis=1)
    y_f = _ssd_scan(xh, dt_f, a_f, bm, cm)
    y_b = flip(_ssd_scan(flip(xh), flip(dt_b), a_b, flip(bm), flip(cm)))
    y = (y_f + y_b + d_skip.astype(jnp.float32)[:, None] * xh).reshape(bsz, s, SSD_WIDTH)
    return _rms_norm(y * jax.nn.silu(z.astype(jnp.float32)), norm_w)


def _dilated_branch(q, k, v, slopes, dilation, radius):
    bsz, s, h, e = q.shape
    w = WIN_BLOCK
    l = s // dilation
    nb = -(-l // w)
    lp = nb * w

    def to_res(t):
        t = t.reshape(bsz, l, dilation, h, e).transpose(0, 2, 1, 3, 4)
        return jnp.pad(t, ((0, 0), (0, 0), (0, lp - l), (0, 0), (0, 0)))

    def neighbours(t):
        tp = jnp.pad(t, ((0, 0), (0, 0), (w, w), (0, 0), (0, 0)))
        return jnp.concatenate([tp[:, :, o:o + lp].reshape(bsz, dilation, nb, w, h, e)
                                for o in (0, w, 2 * w)], axis=3)

    qb = to_res(q).reshape(bsz, dilation, nb, w, h, e)
    kb = neighbours(to_res(k))
    vb = neighbours(to_res(v))
    qi = jnp.arange(nb)[:, None] * w + jnp.arange(w)[None, :]
    kj = (jnp.arange(nb)[:, None] - 1) * w + jnp.arange(3 * w)[None, :]
    rel = kj[:, None, :] - qi[:, :, None]
    valid = (jnp.abs(rel) <= radius) & (kj[:, None, :] >= 0) & (kj[:, None, :] < l)
    dist = (dilation * jnp.abs(rel)).astype(jnp.float32)
    bias = (-slopes[:, None, None, None] * dist[None]).transpose(1, 0, 2, 3)
    sc = jnp.einsum('bdnqhe,bdnkhe->bdnhqk', qb, kb) + bias
    sc = jnp.where(valid[:, None], sc, NEG_INF)
    lse = jax.nn.logsumexp(sc, axis=-1)
    o = jnp.einsum('bdnhqk,bdnkhe->bdnqhe', jnp.exp(sc - lse[..., None]), vb)
    o = o.reshape(bsz, dilation, lp, h, e)[:, :, :l].transpose(0, 2, 1, 3, 4).reshape(bsz, s, h, e)
    lse = lse.transpose(0, 1, 2, 4, 3).reshape(bsz, dilation, lp, h)[:, :, :l]
    lse = lse.transpose(0, 2, 1, 3).reshape(bsz, s, h)
    return o, lse


def _dilated_attention(q, k, v):
    slopes = jnp.asarray(_alibi_slopes())
    outs, lses = [], []
    for window, dilation in DILATED_PATTERNS:
        o, lse = _dilated_branch(q, k, v, slopes, dilation, window // (2 * dilation))
        outs.append(o)
        lses.append(lse)
    wts = jax.nn.softmax(jnp.stack(lses, 0), axis=0)
    y = jnp.einsum('nbsh,nbshe->bshe', wts, jnp.stack(outs, 0))
    return y.reshape(q.shape[0], q.shape[1], ATT_WIDTH)


def _hybrid_mixer(h, w_in, conv_w, conv_b, dt_bias_f, dt_bias_b, a_log_f, a_log_b, d_skip, norm_w, w_out):
    bsz, s, _ = h.shape
    proj = h @ w_in
    z = proj[..., Z_OFF:XBC_OFF]
    xbc = proj[..., XBC_OFF:DT_OFF]
    dt_raw = proj[..., DT_OFF:Q_OFF]
    hd = (bsz, s, ATT_HEADS, ATT_HEAD_DIM)
    q = proj[..., Q_OFF:K_OFF].astype(jnp.float32).reshape(hd) * (ATT_HEAD_DIM ** -0.5)
    k = proj[..., K_OFF:V_OFF].astype(jnp.float32).reshape(hd)
    v = proj[..., V_OFF:IN_COLS].astype(jnp.float32).reshape(hd)
    y_ssd = _ssd_group(z, xbc, dt_raw, conv_w, conv_b, dt_bias_f, dt_bias_b, a_log_f, a_log_b, d_skip, norm_w)
    y_att = _dilated_attention(q, k, v)
    y = jnp.concatenate([y_ssd, y_att], axis=-1).astype(h.dtype)
    return y @ w_out


def _memory_cross_attention(h, mem, wq, wk, wv, wo):
    bsz, s, _ = h.shape
    m = mem.shape[1]
    q = (h @ wq).reshape(bsz, s, MEM_HEADS, MEM_HEAD_DIM).astype(jnp.float32)
    k = (mem @ wk).reshape(bsz, m, MEM_HEADS, MEM_HEAD_DIM).astype(jnp.float32)
    v = (mem @ wv).reshape(bsz, m, MEM_HEADS, MEM_HEAD_DIM).astype(jnp.float32)
    p = jax.nn.softmax(jnp.einsum('bshe,bmhe->bhsm', q, k) * (MEM_HEAD_DIM ** -0.5), axis=-1)
    o = jnp.einsum('bhsm,bmhe->bshe', p, v).reshape(bsz, s, MEM_WIDTH).astype(h.dtype)
    return o @ wo


def _swiglu(x, wg, wu, wd):
    return (jax.nn.silu(x @ wg) * (x @ wu)) @ wd


def _routed_experts(xt, eidx, gates, w_gate, w_up, w_down):
    t, d = xt.shape
    a = t * TOP_K
    e_flat = eidx.reshape(a)
    tok_flat = jnp.arange(a, dtype=jnp.int32) // TOP_K
    order = jnp.argsort(e_flat)
    e_sorted = e_flat[order]
    counts = jnp.bincount(e_flat, length=N_EXPERTS)
    starts = jnp.cumsum(counts) - counts
    padded = (counts + MOE_BLOCK - 1) // MOE_BLOCK * MOE_BLOCK
    pends = jnp.cumsum(padded)
    dest = pends[e_sorted] - padded[e_sorted] + (jnp.arange(a, dtype=jnp.int32) - starts[e_sorted])
    n_blocks = -(-a // MOE_BLOCK) + N_EXPERTS
    n_pad = n_blocks * MOE_BLOCK
    tok_buf = jnp.zeros((n_pad,), jnp.int32).at[dest].set(tok_flat[order])
    gate_buf = jnp.zeros((n_pad,), jnp.float32).at[dest].set(gates.reshape(a)[order])
    block_e = jnp.minimum(jnp.searchsorted(pends, jnp.arange(n_blocks, dtype=jnp.int32) * MOE_BLOCK, side='right'),
                          N_EXPERTS - 1)

    def expert_block(args):
        e, tok, g = args
        xb = xt[tok]
        return _swiglu(xb, w_gate[e], w_up[e], w_down[e]).astype(jnp.float32) * g[:, None]

    outs = lax.map(expert_block, (block_e, tok_buf.reshape(n_blocks, MOE_BLOCK),
                                  gate_buf.reshape(n_blocks, MOE_BLOCK)))
    return jnp.zeros((t, d), jnp.float32).at[tok_buf].add(outs.reshape(n_pad, d))


def _moe_ffn(h, w_router, router_bias, w_gate, w_up, w_down, ws_gate, ws_up, ws_down):
    bsz, s, d = h.shape
    t = bsz * s
    xt = h.reshape(t, d)
    scores = jax.nn.sigmoid((xt @ w_router).astype(jnp.float32))
    choice = scores + router_bias.astype(jnp.float32)
    grp = choice.reshape(t, ROUTE_GROUPS, N_EXPERTS // ROUTE_GROUPS)
    grp_score = lax.top_k(grp, 2)[0].sum(-1)
    _, gidx = lax.top_k(grp_score, TOPK_GROUPS)
    gmask = jax.nn.one_hot(gidx, ROUTE_GROUPS, dtype=jnp.float32).sum(1) > 0
    emask = jnp.repeat(gmask, N_EXPERTS // ROUTE_GROUPS, axis=1)
    _, eidx = lax.top_k(jnp.where(emask, choice, NEG_INF), TOP_K)
    wts = jnp.take_along_axis(scores, eidx, axis=1)
    wts = wts / jnp.sum(wts, -1, keepdims=True) * ROUTED_SCALE
    routed = _routed_experts(xt, eidx, wts, w_gate, w_up, w_down)
    shared = _swiglu(xt, ws_gate, ws_up, ws_down).astype(jnp.float32)
    return (routed + shared).astype(h.dtype).reshape(bsz, s, d)


def setup_inputs(seed: int = 0) -> dict:
    key = jax.random.key(seed)
    ks = jax.random.split(key, 32)
    f32 = jnp.float32
    L = DEPTH
    D = D_MODEL

    def nrm(k, shape, scale):
        return jax.random.normal(k, shape, f32) * scale

    def dt_bias(k):
        dt = jnp.exp(jax.random.uniform(k, (L, SSD_HEADS), f32, math.log(DT_MIN), math.log(DT_MAX)))
        return dt + jnp.log(-jnp.expm1(-dt))

    w_in = nrm(ks[4], (L, D, IN_COLS), D ** -0.5)
    w_in = w_in.at[:, :, V_OFF:].multiply(DN_BETA)
    return {
        'x': nrm(ks[0], (BATCH, SEQ, D), 1.0),
        'mem': nrm(ks[1], (BATCH, MEM_LEN, D), 1.0),
        'ln_in_g': 1.0 + nrm(ks[2], (D,), 0.02),
        'ln_in_b': nrm(ks[3], (D,), 0.02),
        'w_in': w_in,
        'conv_w': nrm(ks[5], (L, SSD_CONV, CONV_CH), SSD_CONV ** -0.5),
        'conv_b': nrm(ks[6], (L, CONV_CH), 0.02),
        'dt_bias_f': dt_bias(ks[7]),
        'dt_bias_b': dt_bias(ks[8]),
        'a_log_f': jnp.log(jax.random.uniform(ks[9], (L, SSD_HEADS), f32, 1.0, 16.0)),
        'a_log_b': jnp.log(jax.random.uniform(ks[10], (L, SSD_HEADS), f32, 1.0, 16.0)),
        'd_skip': 1.0 + nrm(ks[11], (L, SSD_HEADS), 0.1),
        'ssd_norm_w': 1.0 + nrm(ks[12], (L, SSD_WIDTH), 0.02),
        'w_out_mix': nrm(ks[13], (L, MIX_WIDTH, D), MIX_WIDTH ** -0.5 * DN_BETA),
        'ln1_g': 1.0 + nrm(ks[14], (L, D), 0.02),
        'ln1_b': nrm(ks[15], (L, D), 0.02),
        'wq_mem': nrm(ks[16], (L, D, MEM_WIDTH), D ** -0.5),
        'wk_mem': nrm(ks[17], (L, D, MEM_WIDTH), D ** -0.5),
        'wv_mem': nrm(ks[18], (L, D, MEM_WIDTH), D ** -0.5 * DN_BETA),
        'wo_mem': nrm(ks[19], (L, MEM_WIDTH, D), MEM_WIDTH ** -0.5 * DN_BETA),
        'ln2_g': 1.0 + nrm(ks[20], (L, D), 0.02),
        'ln2_b': nrm(ks[21], (L, D), 0.02),
        'w_router': nrm(ks[22], (L, D, N_EXPERTS), D ** -0.5),
        'router_bias': nrm(ks[23], (L, N_EXPERTS), 0.01),
        'w_gate': nrm(ks[24], (L, N_EXPERTS, D, EXPERT_DIM), D ** -0.5),
        'w_up': nrm(ks[25], (L, N_EXPERTS, D, EXPERT_DIM), D ** -0.5),
        'w_down': nrm(ks[26], (L, N_EXPERTS, EXPERT_DIM, D), EXPERT_DIM ** -0.5 * DN_BETA),
        'ws_gate': nrm(ks[27], (L, D, SHARED_DIM), D ** -0.5),
        'ws_up': nrm(ks[28], (L, D, SHARED_DIM), D ** -0.5),
        'ws_down': nrm(ks[29], (L, SHARED_DIM, D), SHARED_DIM ** -0.5 * DN_BETA),
        'ln3_g': 1.0 + nrm(ks[30], (L, D), 0.02),
        'ln3_b': nrm(ks[31], (L, D), 0.02),
    }


def reference(x, mem, ln_in_g, ln_in_b, w_in, conv_w, conv_b, dt_bias_f, dt_bias_b, a_log_f, a_log_b,
              d_skip, ssd_norm_w, w_out_mix, ln1_g, ln1_b, wq_mem, wk_mem, wv_mem, wo_mem, ln2_g, ln2_b,
              w_router, router_bias, w_gate, w_up, w_down, ws_gate, ws_up, ws_down, ln3_g, ln3_b):
    h = _layer_norm(x, ln_in_g, ln_in_b)
    for l in range(DEPTH):
        mix = _hybrid_mixer(h, w_in[l], conv_w[l], conv_b[l], dt_bias_f[l], dt_bias_b[l], a_log_f[l],
                            a_log_b[l], d_skip[l], ssd_norm_w[l], w_out_mix[l])
        h = _layer_norm(DN_ALPHA * h + mix, ln1_g[l], ln1_b[l])
        xa = _memory_cross_attention(h, mem, wq_mem[l], wk_mem[l], wv_mem[l], wo_mem[l])
        h = _layer_norm(DN_ALPHA * h + xa, ln2_g[l], ln2_b[l])
        ff = _moe_ffn(h, w_router[l], router_bias[l], w_gate[l], w_up[l], w_down[l],
                      ws_gate[l], ws_up[l], ws_down[l])
        h = _layer_norm(DN_ALPHA * h + ff, ln3_g[l], ln3_b[l])
    return h
```

```cpp
#include <hip/hip_runtime.h>
#include <hip/hip_cooperative_groups.h>
#include <cstdio>
#include <cstdint>
namespace cg = cooperative_groups;

#define LAS __attribute__((address_space(3)))
typedef unsigned short bf16_t;
typedef short bf16x8 __attribute__((ext_vector_type(8)));
typedef short s16x4 __attribute__((ext_vector_type(4)));
typedef float f32x4 __attribute__((ext_vector_type(4)));
typedef float f32x2 __attribute__((ext_vector_type(2)));
typedef unsigned u32x4 __attribute__((ext_vector_type(4)));
typedef unsigned u32x2 __attribute__((ext_vector_type(2)));
typedef __bf16 bf16x2_t __attribute__((ext_vector_type(2)));

constexpr int T = 32768, D = 1024, SEQ = 2048, NBATCH = 16;
constexpr int NASSIGN = T * 8;
constexpr float DN_ALPHA = 1.189207115002721f;
constexpr float LOG2E = 1.4426950408889634f, LN2 = 0.6931471805599453f, QSCALE = 0.125f * LOG2E;
constexpr int LDS_BYTES = 155648;
constexpr int STG_OFF = 131072;
constexpr int TAB_OFF = 147456;
constexpr size_t MiB = 1u << 20;
constexpr size_t WS_CTL = 0, CTL_BYTES = 1 * MiB;
constexpr size_t WS_WIN = 1 * MiB, WS_WOUT = 14 * MiB, WS_WQ = 18 * MiB, WS_WK = 20 * MiB, WS_WV = 22 * MiB, WS_WO = 24 * MiB,
                 WS_WR = 26 * MiB, WS_WSGU = 27 * MiB, WS_WSD = 28 * MiB;
constexpr size_t WS_DTRAW = 29 * MiB, WS_DTF = 33 * MiB, WS_DTB = 35 * MiB, WS_ECSF = 37 * MiB, WS_ECSB = 39 * MiB, WS_DEC = 41 * MiB,
                 WS_LSE = 42 * MiB, WS_MEMB = 48 * MiB, WS_KM = 56 * MiB, WS_VT = 64 * MiB;
constexpr size_t WS_HB = 72 * MiB, WS_Z = 136 * MiB, WS_XBC = 200 * MiB, WS_STATES = 200 * MiB, WS_QKV = 328 * MiB, WS_YSSD = 328 * MiB,
                 WS_YMIX = 392 * MiB, WS_ATTP1 = 904 * MiB, WS_ATTP2 = 936 * MiB, WS_ATTP3 = 968 * MiB;
constexpr size_t WS_QM = 136 * MiB, WS_XATT = 200 * MiB;
constexpr size_t WS_HB8 = 200 * MiB;
constexpr float H8_SCALE = 16.f, W8_SCALE = 256.f, HID8_SCALE = 16.f;
__device__ __forceinline__ float clamp8(float x) { return __builtin_amdgcn_fmed3f(x, -448.f, 448.f); }
constexpr size_t WS_LOGITS = 136 * MiB, WS_HIDS = 168 * MiB, WS_EIDX = 184 * MiB, WS_POS = 185 * MiB, WS_SLOT = 186 * MiB, WS_GATE = 187 * MiB, WS_TOK = 188 * MiB, WS_BH = 190 * MiB;
constexpr size_t WS_WD = 520 * MiB, WS_WGU = 648 * MiB, WS_YROWS = 712 * MiB, WS_PRE3 = 392 * MiB, WS_HID = 264 * MiB, WS_END = 1024 * MiB;
constexpr int CW_COUNTS = 1024, CW_BAR = 4096;

__device__ __forceinline__ unsigned cvtpk(float lo, float hi) { f32x2 v = {lo, hi}; bf16x2_t b = __builtin_convertvector(v, bf16x2_t); return __builtin_bit_cast(unsigned, b); }
__device__ __forceinline__ float bflo(unsigned w) { return __builtin_bit_cast(float, w << 16); }
__device__ __forceinline__ float bfhi(unsigned w) { return __builtin_bit_cast(float, w & 0xffff0000u); }
__device__ __forceinline__ float bf1(bf16_t h) { return __builtin_bit_cast(float, (unsigned)h << 16); }
__device__ __forceinline__ float wave_sum(float v) {
#pragma unroll
    for (int o = 1; o < 64; o <<= 1) v += __shfl_xor(v, o);
    return v;
}
__device__ __forceinline__ float siluf(float x) { return x * __builtin_amdgcn_rcpf(1.f + __expf(-x)); }
__device__ __forceinline__ int ld_agent(const int* p) { return __hip_atomic_load(p, __ATOMIC_RELAXED, __HIP_MEMORY_SCOPE_AGENT); }
template <int CTRL, int ROWMASK> __device__ __forceinline__ float dppmax(float v) {
    const int o = __builtin_amdgcn_update_dpp(__builtin_bit_cast(int, v), __builtin_bit_cast(int, v), CTRL, ROWMASK, 0xf, false);
    return fmaxf(v, __builtin_bit_cast(float, o));
}
__device__ __forceinline__ float wave_max_dpp(float v) {
    v = dppmax<0x111, 0xf>(v); v = dppmax<0x112, 0xf>(v); v = dppmax<0x114, 0xf>(v); v = dppmax<0x118, 0xf>(v);
    v = dppmax<0x142, 0xa>(v); v = dppmax<0x143, 0xc>(v);
    return __builtin_bit_cast(float, __builtin_amdgcn_readlane(__builtin_bit_cast(int, v), 63));
}
#define LDS_WAIT() asm volatile("s_waitcnt lgkmcnt(0)" ::: "memory")
__device__ __forceinline__ int lane_id() { return (int)__builtin_amdgcn_mbcnt_hi(~0u, __builtin_amdgcn_mbcnt_lo(~0u, 0u)); }
__device__ __forceinline__ s16x4 vtr(LAS const unsigned char* p) {
    typedef short v4i16_t __attribute__((ext_vector_type(4)));
    return __builtin_bit_cast(s16x4, __builtin_amdgcn_ds_read_tr16_b64_v4i16((LAS v4i16_t*)p));
}
__device__ __forceinline__ bf16x8 cat8(s16x4 lo, s16x4 hi) { return (bf16x8){lo[0], lo[1], lo[2], lo[3], hi[0], hi[1], hi[2], hi[3]}; }
#define MFMA16(a, b, c) __builtin_amdgcn_mfma_f32_16x16x32_bf16((a), (b), (c), 0, 0, 0)

#ifndef PHMASK
#define PHMASK 0xFFFFFFu
#endif
#define PH_EN(n) (((PHMASK) >> (n)) & 1u)
#ifndef GEMM_ONLY
#define GEMM_ONLY -1
#endif
#define JP(n) (GEMM_ONLY < 0 || GEMM_ONLY == (n))
struct Args { const float* in[32]; float* out; unsigned char* ws; int ph_lo, ph_hi; };

namespace pg8 {
constexpr int BM = 256, BK = 64, HALF = 128, HTB = HALF * BK * 2, STAGE_BYTES = 8 * HTB, NXCD = 8, WGM = 8;
__device__ __forceinline__ int lds_byte(int r, int c) { const int st = (r >> 4) * 2 + (c >> 5), rr = r & 15, cc = c & 31, ob = rr * 64 + cc * 2; return st * 1024 + (ob ^ (((ob >> 9) & 1) << 5)); }
__device__ __forceinline__ void stage_rc(int b, int& R, int& C) { const int st = b / 1024, sb = b % 1024, swz = sb ^ (((sb >> 9) & 1) << 5); R = (st >> 1) * 16 + swz / 64; C = (st & 1) * 32 + (swz % 64) / 2; }
__device__ __forceinline__ int perm32(int rho) { const int n = rho >> 4, i = rho & 15; return 8 * (i >> 2) + 4 * n + (i & 3); }

enum { M_PROJ = 0, M_BF16 = 1, M_RESBF16 = 2, M_F32 = 3, M_GATEUP = 4, M_FP8ROWS = 5, M_GATEUP8 = 6 };
struct GJob { const bf16_t* A; const bf16_t* Bt; int M, N, K, ldo; float alpha;
              void* o0; void* o1; void* o2; void* o3; const bf16_t* res; const int* tok; const bf16_t* xA; const bf16_t* xB; void* xO; };
struct GUnit { const char* a; const char* b; int orow, ocol, nvalid, pn, slot0; };

typedef int i32x8 __attribute__((ext_vector_type(8)));
typedef int i32x4_t __attribute__((ext_vector_type(4)));
typedef long i64x2_t __attribute__((ext_vector_type(2)));
__device__ __forceinline__ i32x8 cat32(bf16x8 lo, bf16x8 hi) { const i32x4_t a = __builtin_bit_cast(i32x4_t, lo), b = __builtin_bit_cast(i32x4_t, hi); return __builtin_shufflevector(a, b, 0, 1, 2, 3, 4, 5, 6, 7); }
template <int KIND> __device__ __forceinline__ bool gnext(const GJob& g, LAS const int* tabs, int G, int c, int vc, int i, GUnit& u) {
    if (KIND == 0) {
        const int nM = g.M / BM, nN = g.N / BM, nwg = nM * nN;
        const long L = (long)i * G + c;
        if (g.xA != nullptr && L >= nwg) {
            const int x = (int)L - nwg; if (x >= 128) return false;
            const int pm = x >> 3, pn = x & 7;
            u.a = (const char*)g.xA + (size_t)pm * BM * g.K * 2; u.b = (const char*)g.xB + (size_t)pn * BM * g.K * 2;
            u.orow = pm * BM; u.ocol = pn * BM; u.nvalid = BM; u.pn = 100 + pn; u.slot0 = 0; return true;
        }
        if (L >= nwg) return false;
        int wgid = (int)L; { const int q = nwg / NXCD, r = nwg % NXCD, xcd = wgid % NXCD, off = wgid / NXCD; wgid = (xcd < r ? xcd * (q + 1) : r * (q + 1) + (xcd - r) * q) + off; }
        const int nig = WGM * nN, gid = wgid / nig, fm = gid * WGM, gsz = (nM - fm) < WGM ? (nM - fm) : WGM;
        const int pm = fm + ((wgid % nig) % gsz), pn = (wgid % nig) / gsz;
        u.a = (const char*)g.A + (size_t)pm * BM * g.K * 2; u.b = (const char*)g.Bt + (size_t)pn * BM * g.K * 2;
        u.orow = pm * BM; u.ocol = pn * BM; u.nvalid = BM; u.pn = pn; u.slot0 = 0; return true;
    }
    LAS const int* CN = tabs; LAS const int* TP = tabs + 256; LAS const int* SB = tabs + 256 + 260;
    const int ncol = KIND == 1 ? 2 : 4;
#define RFL(x) __builtin_amdgcn_readfirstlane(x)
    const int L = i * G + vc; if (L >= RFL(TP[256]) * ncol) return false;
    const int tile = L / ncol, pn = L % ncol;
    int lo = 0, hi = 256;
    while (hi - lo > 1) { const int mid = (lo + hi) >> 1; if (RFL(TP[mid]) <= tile) lo = mid; else hi = mid; }
    const int e = lo, tin = tile - RFL(TP[e]), slot0 = RFL(SB[e]) + tin * 256; int nv = RFL(CN[e]) - tin * 256; nv = nv > 256 ? 256 : nv;
#undef RFL
    u.orow = slot0; u.slot0 = slot0; u.nvalid = nv; u.pn = pn;
    if (KIND == 1) { u.a = (const char*)g.A; u.b = (const char*)g.Bt + ((size_t)e * 512 + pn * 256) * g.K * 2; u.ocol = pn * 128; }
    else { u.a = (const char*)g.A + (size_t)slot0 * g.K * 2; u.b = (const char*)g.Bt + ((size_t)e * 1024 + pn * 256) * g.K * 2; u.ocol = pn * 256; }
    return true;
}
template <int KIND> __device__ __forceinline__ void unit_voff(const GJob& g, const GUnit& u, int tid, unsigned (&v)[2][2]) {
#pragma unroll
    for (int i = 0; i < 2; ++i) {
        int R, C; stage_rc(tid * 16 + i * 8192, R, C);
#pragma unroll
        for (int h = 0; h < 2; ++h) {
            if (KIND == 1) { int s = u.slot0 + h * HALF + R; s = s < NASSIGN ? s : NASSIGN - 1; const int tk = g.tok[s]; v[h][i] = (unsigned)(tk * g.K + C) * 2u; }
            else v[h][i] = (unsigned)(R * g.K + C) * 2u;
        }
    }
}

__device__ __forceinline__ void stg_write(LAS unsigned char* wst, int fr, int slot, u32x4 v) { *(LAS u32x4*)(wst + fr * 128 + ((slot ^ (fr & 7)) << 4)) = v; }
__device__ __forceinline__ u32x4 stg_read(LAS const unsigned char* wst, int r, int c) { return *(const LAS u32x4*)(wst + r * 128 + ((c ^ (r & 7)) << 4)); }
__device__ __forceinline__ void stg_write2(LAS unsigned char* alt, int fr, int slot, u32x4 v) { *(LAS u32x4*)(alt + (fr >> 3) * 8192 + (fr & 7) * 128 + ((slot ^ (fr & 7)) << 4)) = v; }
__device__ __forceinline__ u32x4 stg_read2(LAS const unsigned char* alt, int r, int c) { return *(const LAS u32x4*)(alt + (r >> 3) * 8192 + (r & 7) * 128 + ((c ^ (r & 7)) << 4)); }
template <int MODE> __device__ __forceinline__ void gemm_epi(const GJob& g, const GUnit& u, const f32x4 (&acc)[2][2][4][2], LAS unsigned char* wst, int wr, int wc, int fr, int fq) {
    LAS unsigned char* alt = wst + (3 * HTB - STG_OFF) - (wr * 4 + wc) * 1024;
    const int lane = fq * 16 + fr, rr0 = lane >> 3, cc = lane & 7;
    if (MODE == M_PROJ || MODE == M_BF16 || MODE == M_RESBF16) {
        bf16_t* base = (bf16_t*)g.o0; int ld = g.ldo, c0 = u.ocol;
        if (MODE == M_PROJ) {
            const int pn = u.pn;
            if (pn == 24) {
                if (wc == 0) { float* dt = (float*)g.o3;
#pragma unroll
                    for (int ai = 0; ai < 2; ++ai)
#pragma unroll
                        for (int m = 0; m < 4; ++m) { float* p = dt + (size_t)(u.orow + ai * HALF + wr * 64 + m * 16 + fr) * 32 + 8 * fq; *(f32x4*)p = acc[ai][0][m][0]; *(f32x4*)(p + 4) = acc[ai][0][m][1]; } }
                return;
            }
            if (pn < 4) { base = (bf16_t*)g.o0; ld = 1024; c0 = pn * 256; } else if (pn < 12) { base = (bf16_t*)g.o1; ld = 2048; c0 = (pn - 4) * 256; } else if (pn < 24) {
                base = (bf16_t*)g.o2 + ((size_t)((((pn - 12) >> 2) * 16 + (u.orow >> 11)) * 16 + 4 * ((pn - 12) & 3) + wc) * SEQ + (u.orow & (SEQ - 1))) * 64 - (size_t)u.orow * 64; ld = 64; c0 = -wc * 64; }
            else { base = (bf16_t*)g.xO; ld = 2048; c0 = (pn - 100) * 256; }
        }
        const float osc = (MODE == M_PROJ && u.pn >= 12 && u.pn < 16) ? QSCALE : 1.f;
#define EPI_STAGE(ck_) do { const int ai_ = (ck_) >> 2, m_ = (ck_) & 3; _Pragma("unroll") for (int bj = 0; bj < 2; ++bj) { const f32x4 v0 = acc[ai_][bj][m_][0] * osc, v1 = acc[ai_][bj][m_][1] * osc; \
            u32x4 w_; w_.x = cvtpk(v0[0], v0[1]); w_.y = cvtpk(v0[2], v0[3]); w_.z = cvtpk(v1[0], v1[1]); w_.w = cvtpk(v1[2], v1[3]); if ((ck_) & 1) stg_write2(alt, fr, 4 * bj + fq, w_); else stg_write(wst, fr, 4 * bj + fq, w_); } } while (0)
        EPI_STAGE(0);
#pragma unroll
        for (int ck = 0; ck < 8; ++ck) { const int ai = ck >> 2, m = ck & 3;
            u32x4 wv[2];
#pragma unroll
            for (int i = 0; i < 2; ++i) wv[i] = (ck & 1) ? stg_read2(alt, 8 * i + rr0, cc) : stg_read(wst, 8 * i + rr0, cc);
            __builtin_amdgcn_sched_barrier(0);
            if (ck < 7) EPI_STAGE(ck + 1);
            __builtin_amdgcn_sched_barrier(0);
#pragma unroll
            for (int i = 0; i < 2; ++i) { const int r = 8 * i + rr0, rl = ai * HALF + wr * 64 + m * 16 + r;
                u32x4 w = wv[i];
                if (rl < u.nvalid) { const size_t o = (size_t)(u.orow + rl) * ld + c0 + wc * 64 + 8 * cc;
                    if (MODE == M_RESBF16) { const u32x4 rs = *(const u32x4*)(g.res + o);
                        w.x = cvtpk(bflo(w.x) + g.alpha * bflo(rs.x), bfhi(w.x) + g.alpha * bfhi(rs.x)); w.y = cvtpk(bflo(w.y) + g.alpha * bflo(rs.y), bfhi(w.y) + g.alpha * bfhi(rs.y));
                        w.z = cvtpk(bflo(w.z) + g.alpha * bflo(rs.z), bfhi(w.z) + g.alpha * bfhi(rs.z)); w.w = cvtpk(bflo(w.w) + g.alpha * bflo(rs.w), bfhi(w.w) + g.alpha * bfhi(rs.w)); }
                    *(u32x4*)(base + o) = w; } }
            __builtin_amdgcn_sched_barrier(0);
        }
#undef EPI_STAGE
    } else if (MODE == M_F32) {
        float* out = (float*)g.o0;
#pragma unroll
        for (int ai = 0; ai < 2; ++ai)
#pragma unroll
            for (int m = 0; m < 4; ++m)
#pragma unroll
                for (int bj = 0; bj < 2; ++bj) {
#pragma unroll
                    for (int n = 0; n < 2; ++n) stg_write(wst, fr, 4 * n + fq, __builtin_bit_cast(u32x4, acc[ai][bj][m][n]));
                    asm volatile("" ::: "memory");
#pragma unroll
                    for (int i = 0; i < 2; ++i) { const int r = 8 * i + rr0, rl = ai * HALF + wr * 64 + m * 16 + r;
                        const u32x4 w = stg_read(wst, r, cc);
                        if (rl < u.nvalid) *(u32x4*)(out + (size_t)(u.orow + rl) * g.ldo + u.ocol + wc * 64 + bj * 32 + 4 * cc) = w; }
                    asm volatile("" ::: "memory");
                }
    } else if (MODE == M_FP8ROWS) {
        unsigned char* out = (unsigned char*)g.o0;
#pragma unroll
        for (int ai = 0; ai < 2; ++ai)
#pragma unroll
            for (int m = 0; m < 4; ++m) {
#pragma unroll
                for (int bj = 0; bj < 2; ++bj) { const f32x4 v0 = acc[ai][bj][m][0] * (32.f / (HID8_SCALE * W8_SCALE)), v1 = acc[ai][bj][m][1] * (32.f / (HID8_SCALE * W8_SCALE));
                    int w0 = 0, w1 = 0;
                    w0 = __builtin_amdgcn_cvt_pk_fp8_f32(v0[0], v0[1], w0, false); w0 = __builtin_amdgcn_cvt_pk_fp8_f32(v0[2], v0[3], w0, true);
                    w1 = __builtin_amdgcn_cvt_pk_fp8_f32(v1[0], v1[1], w1, false); w1 = __builtin_amdgcn_cvt_pk_fp8_f32(v1[2], v1[3], w1, true);
                    u32x2 w; w.x = (unsigned)w0; w.y = (unsigned)w1;
                    *(LAS u32x2*)(wst + fr * 64 + (((2 * bj + (fq >> 1)) ^ (fr & 3)) << 4) + (fq & 1) * 8) = w; }
                asm volatile("" ::: "memory");
                { const int r = lane >> 2, c4 = lane & 3, rl = ai * HALF + wr * 64 + m * 16 + r;
                  const u32x4 w = *(const LAS u32x4*)(wst + r * 64 + ((c4 ^ (r & 3)) << 4));
                  if (rl < u.nvalid) *(u32x4*)(out + (size_t)(u.orow + rl) * 1024 + u.ocol + wc * 64 + 16 * c4) = w; }
                asm volatile("" ::: "memory");
            }
    } else if (MODE == M_GATEUP8) {
        unsigned char* out = (unsigned char*)g.o0; const float isc = 1.f / (H8_SCALE * W8_SCALE);
#pragma unroll
        for (int ai = 0; ai < 2; ++ai)
#pragma unroll
            for (int m = 0; m < 4; ++m) { const int rl = ai * HALF + wr * 64 + m * 16 + fr;
                if (rl < u.nvalid) { unsigned char* rowp = out + (size_t)(u.orow + rl) * 256 + u.pn * 128 + wc * 32 + 8 * fq;
                    float hv[8];
#pragma unroll
                    for (int n = 0; n < 2; ++n)
#pragma unroll
                        for (int j = 0; j < 4; ++j) hv[n * 4 + j] = clamp8(siluf(acc[ai][0][m][n][j] * isc) * (acc[ai][1][m][n][j] * (isc * HID8_SCALE)));
                    int w0 = 0, w1 = 0;
                    w0 = __builtin_amdgcn_cvt_pk_fp8_f32(hv[0], hv[1], w0, false); w0 = __builtin_amdgcn_cvt_pk_fp8_f32(hv[2], hv[3], w0, true);
                    w1 = __builtin_amdgcn_cvt_pk_fp8_f32(hv[4], hv[5], w1, false); w1 = __builtin_amdgcn_cvt_pk_fp8_f32(hv[6], hv[7], w1, true);
                    u32x2 w; w.x = (unsigned)w0; w.y = (unsigned)w1; *(u32x2*)rowp = w; } }
    } else {
        bf16_t* out = (bf16_t*)g.o0;
#pragma unroll
        for (int ai = 0; ai < 2; ++ai)
#pragma unroll
            for (int m = 0; m < 4; ++m) { const int rl = ai * HALF + wr * 64 + m * 16 + fr;
                if (rl < u.nvalid) { bf16_t* rowp = out + (size_t)(u.orow + rl) * 256 + u.pn * 128 + wc * 32 + 8 * fq;
                    float hv[8];
#pragma unroll
                    for (int n = 0; n < 2; ++n)
#pragma unroll
                        for (int j = 0; j < 4; ++j) hv[n * 4 + j] = siluf(acc[ai][0][m][n][j]) * acc[ai][1][m][n][j];
                    u32x4 w; w.x = cvtpk(hv[0], hv[1]); w.y = cvtpk(hv[2], hv[3]); w.z = cvtpk(hv[4], hv[5]); w.w = cvtpk(hv[6], hv[7]); *(u32x4*)rowp = w; } }
    }
}

template <int KIND, int MODE, int PERM, int F8 = 0> __device__ __forceinline__ void gemm_phase(LAS unsigned char* lds, const GJob& g, int G, int cidx, int vcu, int wvx, int u_lo = 0, int u_hi = 1 << 30) {
    int tid = wvx * 64 + lane_id(); asm volatile("" : "+v"(tid));
    const int wid = __builtin_amdgcn_readfirstlane(tid >> 6), lane = tid & 63, wr = wid >> 2, wc = wid & 3, fr = lane & 15, fq = lane >> 4;
    const int K = g.K, nt = K / BK;
    LAS const int* tabs = (LAS const int*)(lds + TAB_OFF);
    unsigned voffB[2];
#pragma unroll
    for (int i = 0; i < 2; ++i) { int R, C; stage_rc(tid * 16 + i * 8192, R, C); const int rho = PERM ? perm32(R & 31) : (R & 31); voffB[i] = (unsigned)((64 * (R >> 5) + rho) * K + C) * 2u; }
    const size_t hstepB = (size_t)32 * K * 2, hstepA = (KIND == 1) ? 0 : (size_t)HALF * K * 2;
    LAS unsigned char* wst = lds + STG_OFF + wid * 2048;
#define VA1 vA[KIND == 1 ? 1 : 0]
    const size_t kstep = (size_t)(BK * 2);
    const unsigned ldsw = (unsigned)wid * 1024u;
    const int aoff = lds_byte(wr * 64 + fr, fq * 8), boff = lds_byte(wc * 32 + fr, fq * 8);
#define PG8_SA(b, h) (((b) * 2 + (h)) * HTB)
#define PG8_SB(b, h) ((4 + (b) * 2 + (h)) * HTB)
#define PG8_STG(bufoff, gbase, voff) do { _Pragma("unroll") for (int _i = 0; _i < 2; ++_i) \
        __builtin_amdgcn_global_load_lds((const unsigned*)((const char*)(gbase) + (voff)[_i]), (LAS unsigned*)(lds + (bufoff) + ldsw + _i * 8192), 16, 0, 0); } while (0)
#define PG8_LDA(dst, b, h) do { _Pragma("unroll") for (int m = 0; m < 4; ++m) _Pragma("unroll") for (int k = 0; k < 2; ++k) dst[m][k] = *(const LAS bf16x8*)(lds + PG8_SA(b, h) + aoff + m * 2048 + k * 1024); } while (0)
#define PG8_LDB(dst, b, h) do { _Pragma("unroll") for (int n = 0; n < 2; ++n) _Pragma("unroll") for (int k = 0; k < 2; ++k) dst[n][k] = *(const LAS bf16x8*)(lds + PG8_SB(b, h) + boff + n * 2048 + k * 1024); } while (0)
#define PG8_MMA(ai, bj, At, Bt) do { __builtin_amdgcn_s_setprio(1); _Pragma("unroll") for (int m = 0; m < 4; ++m) _Pragma("unroll") for (int n = 0; n < 2; ++n) { \
        if (F8 == 2) { const i32x8 b8_ = cat32(Bt[n][0], Bt[n][1]), a8_ = cat32(At[m][0], At[m][1]); asm volatile("v_mfma_scale_f32_16x16x128_f8f6f4 %0, %1, %2, %0, %3, %3 op_sel_hi:[0,0,0]" : "+v"(acc[ai][bj][m][n]) : "v"(b8_), "v"(a8_), "v"(sc1_)); } \
        else if (F8) acc[ai][bj][m][n] = __builtin_amdgcn_mfma_scale_f32_16x16x128_f8f6f4(cat32(Bt[n][0], Bt[n][1]), cat32(At[m][0], At[m][1]), acc[ai][bj][m][n], 0, 0, 0, 0x7F7F7F7F, 0, 0x7F7F7F7F); \
        else { _Pragma("unroll") for (int k = 0; k < 2; ++k) acc[ai][bj][m][n] = __builtin_amdgcn_mfma_f32_16x16x32_bf16(Bt[n][k], At[m][k], acc[ai][bj][m][n], 0, 0, 0); } } __builtin_amdgcn_s_setprio(0); } while (0)
#define PG8_WAIT_V(n) asm volatile("s_waitcnt vmcnt(" #n ")" ::: "memory")
#define PG8_WAIT_L(n) asm volatile("s_waitcnt lgkmcnt(" #n ")" ::: "memory")
#define PG8_BAR __builtin_amdgcn_s_barrier()
#define PG8_SCHED __builtin_amdgcn_sched_barrier(0)
    int sc1_ = 0x7F7F7F7F; if (F8 == 2) asm volatile("" : "+v"(sc1_));
    GUnit cur, nxt; int ui = u_lo;
    while (ui < u_hi && gnext<KIND>(g, tabs, G, cidx, vcu, ui, cur)) {
        unsigned vA[2][2];
        unit_voff<KIND>(g, cur, tid, vA);
        f32x4 acc[2][2][4][2];
#pragma unroll
        for (int a = 0; a < 2; ++a)
#pragma unroll
            for (int b = 0; b < 2; ++b)
#pragma unroll
                for (int m = 0; m < 4; ++m)
#pragma unroll
                    for (int n = 0; n < 2; ++n) acc[a][b][m][n] = (f32x4){0.f, 0.f, 0.f, 0.f};
        bf16x8 At[4][2], B0[2][2], B1[2][2];
        const char* cA = cur.a; const char* cB = cur.b;
        PG8_STG(PG8_SB(0, 0), cB, voffB); PG8_STG(PG8_SB(0, 1), cB + hstepB, voffB); PG8_STG(PG8_SA(0, 0), cA, vA[0]); PG8_STG(PG8_SA(0, 1), cA + hstepA, VA1);
        if (wr == 1) PG8_BAR;
        PG8_WAIT_V(2); PG8_BAR;
        PG8_STG(PG8_SB(1, 0), cB + kstep, voffB); PG8_STG(PG8_SA(1, 0), cA + kstep, vA[0]); PG8_STG(PG8_SB(1, 1), cB + hstepB + kstep, voffB);
        PG8_WAIT_V(6); PG8_BAR;
        for (;;) {
            const bool has_next = (ui + 1 < u_hi) && gnext<KIND>(g, tabs, G, cidx, vcu, ui + 1, nxt);
            if (KIND == 1 && has_next) {
                unsigned nv[2][2]; unit_voff<KIND>(g, nxt, tid, nv);
                *(LAS u32x4*)(lds + STG_OFF + tid * 16) = (u32x4){nv[0][0], nv[0][1], nv[1][0], nv[1][1]};
            }
            const char* nA = has_next ? nxt.a : cA; const char* nB = has_next ? nxt.b : cB;
            for (int t = 0; t < nt; t += 2) {
                const bool last = (t == nt - 2);
                const char* a1 = cA + (size_t)(t + 1) * kstep;
                const char* a2 = last ? nA : cA + (size_t)(t + 2) * kstep; const char* b2 = last ? nB : cB + (size_t)(t + 2) * kstep;
                const char* a3 = a2 + kstep; const char* b3 = b2 + kstep;
                PG8_LDB(B0, 0, 0); PG8_LDB(B1, 0, 1); PG8_SCHED; PG8_LDA(At, 0, 0); PG8_STG(PG8_SA(1, 1), a1 + hstepA, VA1);
                if (KIND == 1 && last && has_next) {
                    const u32x4 nv = *(const LAS u32x4*)(lds + STG_OFF + tid * 16); vA[0][0] = nv.x; vA[0][1] = nv.y; vA[1][0] = nv.z; vA[1][1] = nv.w; }
                PG8_WAIT_V(8); PG8_WAIT_L(0); PG8_BAR; PG8_MMA(0, 0, At, B0); PG8_MMA(0, 1, At, B1); PG8_BAR; PG8_SCHED;
                PG8_LDA(At, 0, 1); PG8_STG(PG8_SB(0, 0), b2, voffB); PG8_STG(PG8_SB(0, 1), b2 + hstepB, voffB); PG8_STG(PG8_SA(0, 0), a2, vA[0]);
                PG8_WAIT_V(8); PG8_WAIT_L(0); PG8_BAR; PG8_MMA(1, 0, At, B0); PG8_MMA(1, 1, At, B1); PG8_BAR; PG8_SCHED;
                PG8_LDB(B0, 1, 0); PG8_LDB(B1, 1, 1); PG8_SCHED; PG8_LDA(At, 1, 0); PG8_STG(PG8_SA(0, 1), a2 + hstepA, VA1);
                PG8_WAIT_V(8); PG8_WAIT_L(0); PG8_BAR; PG8_MMA(0, 0, At, B0); PG8_MMA(0, 1, At, B1); PG8_BAR; PG8_SCHED;
                PG8_LDA(At, 1, 1); PG8_STG(PG8_SB(1, 0), b3, voffB); PG8_STG(PG8_SB(1, 1), b3 + hstepB, voffB); PG8_STG(PG8_SA(1, 0), a3, vA[0]);
                PG8_WAIT_V(8); PG8_WAIT_L(0); PG8_BAR; PG8_MMA(1, 0, At, B0); PG8_MMA(1, 1, At, B1); PG8_BAR; PG8_SCHED;
            }
            if (wr == 0) PG8_BAR;
            if (F8 == 2) asm volatile("s_nop 15\n\ts_nop 15\n\ts_nop 15" ::: "memory");
            gemm_epi<MODE>(g, cur, acc, wst, wr, wc, fr, fq);
            ++ui;
            if (!has_next) break;
#pragma unroll
            for (int a = 0; a < 2; ++a)
#pragma unroll
                for (int b = 0; b < 2; ++b)
#pragma unroll
                    for (int m = 0; m < 4; ++m)
#pragma unroll
                        for (int n = 0; n < 2; ++n) acc[a][b][m][n] = (f32x4){0.f, 0.f, 0.f, 0.f};
            cur = nxt; cA = nA; cB = nB;
            if (wr == 1) PG8_BAR;
        }
        PG8_WAIT_V(0);
        PG8_BAR;
    }
#undef VA1
#undef PG8_SA
#undef PG8_SB
#undef PG8_STG
#undef PG8_LDA
#undef PG8_LDB
#undef PG8_MMA
#undef PG8_WAIT_V
#undef PG8_WAIT_L
#undef PG8_BAR
#undef PG8_SCHED
}
}

struct TrJob { const float* W; bf16_t* WT; int ldw, ncols, K, ldt, map, p0; };
__device__ __forceinline__ int tr_row(const TrJob& j, int n) {
    if (j.map == 0) return n + j.p0;
    if (j.map == 1) return n < 3072 ? n : (n < 3104 ? 6144 + (n - 3072) : n - 32);
    return 256 * (n >> 7) + 64 * ((n & 127) >> 5) + (n & 31) + j.p0;
}
template <bool CHK> __device__ __forceinline__ void tr_load(const TrJob& j, int item, f32x4 (&v)[16], int lane) {
    const int nnb = (j.ncols + 63) >> 6, kb = item / nnb, nb = item % nnb, k0 = kb * 64, n0 = nb * 64;
    const int q = lane & 15, r = lane >> 4, n = n0 + 4 * q;
    const float* p = j.W + (size_t)(k0 + r) * j.ldw + n; const size_t step = (size_t)4 * j.ldw;
#pragma unroll
    for (int it = 0; it < 16; ++it) {
        v[it] = (f32x4){0.f, 0.f, 0.f, 0.f};
        if (!CHK || n < j.ncols) v[it] = *(const f32x4*)p;
        p += step;
    }
}
template <bool CHK> __device__ __forceinline__ void tr_finish(const TrJob& j, int item, const f32x4 (&v)[16], LAS float* scr, int lane) {
    const int nnb = (j.ncols + 63) >> 6, kb = item / nnb, nb = item % nnb, k0 = kb * 64, n0 = nb * 64;
    const int q = lane & 15, r = lane >> 4;
#pragma unroll
    for (int it = 0; it < 16; ++it) { const int kk = it * 4 + r; LAS float* s = scr + kk * 65 + 4 * q; s[0] = v[it][0]; s[1] = v[it][1]; s[2] = v[it][2]; s[3] = v[it][3]; }
    LDS_WAIT();
    const int c = lane & 7;
#pragma unroll
    for (int it = 0; it < 8; ++it) {
        const int nn = it * 8 + (lane >> 3), n = n0 + nn;
        if (!CHK || n < j.ncols) {
            const LAS float* s = scr + (8 * c) * 65 + nn;
            u32x4 o; o.x = cvtpk(s[0], s[65]); o.y = cvtpk(s[2 * 65], s[3 * 65]); o.z = cvtpk(s[4 * 65], s[5 * 65]); o.w = cvtpk(s[6 * 65], s[7 * 65]);
            *(u32x4*)(j.WT + (size_t)tr_row(j, n) * j.ldt + k0 + 8 * c) = o;
        }
    }
    LDS_WAIT();
}
template <bool CHK> __device__ __forceinline__ void tr_finish8(const TrJob& j, int item, const f32x4 (&v)[16], LAS float* scr, int lane) {
    const int nnb = (j.ncols + 63) >> 6, kb = item / nnb, nb = item % nnb, k0 = kb * 64, n0 = nb * 64;
    const int q = lane & 15, r = lane >> 4;
#pragma unroll
    for (int it = 0; it < 16; ++it) { const int kk = it * 4 + r; LAS float* s = scr + kk * 65 + 4 * q; s[0] = v[it][0]; s[1] = v[it][1]; s[2] = v[it][2]; s[3] = v[it][3]; }
    LDS_WAIT();
    const int c4 = lane & 3;
#pragma unroll
    for (int it = 0; it < 4; ++it) {
        const int nn = it * 16 + (lane >> 2), n = n0 + nn;
        if (!CHK || n < j.ncols) {
            const LAS float* s = scr + (16 * c4) * 65 + nn;
            u32x4 o;
#pragma unroll
            for (int qq = 0; qq < 4; ++qq) { int w = 0;
                w = __builtin_amdgcn_cvt_pk_fp8_f32(clamp8(s[(4 * qq) * 65] * W8_SCALE), clamp8(s[(4 * qq + 1) * 65] * W8_SCALE), w, false);
                w = __builtin_amdgcn_cvt_pk_fp8_f32(clamp8(s[(4 * qq + 2) * 65] * W8_SCALE), clamp8(s[(4 * qq + 3) * 65] * W8_SCALE), w, true); o[qq] = (unsigned)w; }
            *(u32x4*)((unsigned char*)j.WT + (size_t)tr_row(j, n) * j.ldt + k0 + 16 * c4) = o;
        }
    }
    LDS_WAIT();
}
template <bool CHK = false, bool F8 = false> __device__ __forceinline__ void tr_run(const TrJob& j, int nrep, size_t wstride, size_t tstride, LAS float* scr, int gw, int NGW, int lane, int& off) {
    const int per = (j.K / 64) * ((j.ncols + 63) >> 6); const long total = (long)per * nrep;
    long start = ((long)gw - off) % NGW; if (start < 0) start += NGW;
    off = (int)((off + total) % NGW);
#define TR_JOB(jj, it) TrJob jj = j; { const int e_ = (int)((it) / per); jj.W += (size_t)e_ * wstride; jj.WT += (size_t)e_ * tstride; }
    long it = start;
    for (; it + (long)NGW < total; it += 2 * (long)NGW) {
        f32x4 va[16], vb[16];
        const long i1 = it + NGW;
        { TR_JOB(j0, it); tr_load<CHK>(j0, (int)(it % per), va, lane); }
        __builtin_amdgcn_sched_barrier(0);
        { TR_JOB(j1, i1); tr_load<CHK>(j1, (int)(i1 % per), vb, lane); }
        __builtin_amdgcn_sched_barrier(0);
        { TR_JOB(j0, it); if (F8) tr_finish8<CHK>(j0, (int)(it % per), va, scr, lane); else tr_finish<CHK>(j0, (int)(it % per), va, scr, lane); }
        __builtin_amdgcn_sched_barrier(0);
        { TR_JOB(j1, i1); if (F8) tr_finish8<CHK>(j1, (int)(i1 % per), vb, scr, lane); else tr_finish<CHK>(j1, (int)(i1 % per), vb, scr, lane); }
    }
    for (; it < total; it += NGW) { f32x4 va[16]; TR_JOB(j0, it); tr_load<CHK>(j0, (int)(it % per), va, lane); if (F8) tr_finish8<CHK>(j0, (int)(it % per), va, scr, lane); else tr_finish<CHK>(j0, (int)(it % per), va, scr, lane); }
#undef TR_JOB
}

__device__ __forceinline__ void convert_expert_weights(const float* wg, const float* wu, const float* wd, unsigned char* ws, LAS unsigned char* lds, int vcu, int NGW, int wvx) {
    int tid = wvx * 64 + lane_id(); asm volatile("" : "+v"(tid));
    const int lane = tid & 63, wave = __builtin_amdgcn_readfirstlane(tid >> 6), gw = vcu * 8 + wave;
    LAS float* scr = (LAS float*)(lds + wave * (64 * 65 * 4)); int off = 0;
    TrJob j; j.ldw = 256; j.ncols = 256; j.K = 1024; j.ldt = 1024; j.map = 2; j.WT = (bf16_t*)(ws + WS_WGU);
    j.W = wg; j.p0 = 0; tr_run<false, true>(j, 256, (size_t)1024 * 256, (size_t)512 * 1024 / 2, scr, gw, NGW, lane, off);
    j.W = wu; j.p0 = 32; tr_run<false, true>(j, 256, (size_t)1024 * 256, (size_t)512 * 1024 / 2, scr, gw, NGW, lane, off);
    j.ldw = 1024; j.ncols = 1024; j.K = 256; j.ldt = 256; j.map = 0; j.p0 = 0; j.WT = (bf16_t*)(ws + WS_WD); j.W = wd;
    tr_run<false, true>(j, 256, (size_t)256 * 1024, (size_t)1024 * 256 / 2, scr, gw, NGW, lane, off);
}

template <bool OUT_BF16, bool CONSEC = false>
__device__ __forceinline__ void ln_store(f32x4 (&v)[4], const float* g, const float* b, void* orow, int lane) {
    float s = 0.f;
#pragma unroll
    for (int j = 0; j < 4; ++j) s += (v[j].x + v[j].y) + (v[j].z + v[j].w);
    const float mean = wave_sum(s) * (1.f / D); float s2 = 0.f;
#pragma unroll
    for (int j = 0; j < 4; ++j) { v[j] = v[j] - mean; s2 += (v[j].x * v[j].x + v[j].y * v[j].y) + (v[j].z * v[j].z + v[j].w * v[j].w); }
    const float rstd = 1.f / sqrtf(wave_sum(s2) * (1.f / D) + 1e-5f);
#pragma unroll
    for (int j = 0; j < 4; ++j) {
        const int ci = CONSEC ? 4 * lane + j : lane + 64 * j;
        const f32x4 gg = ((const f32x4*)g)[ci], bb = ((const f32x4*)b)[ci];
        const f32x4 o = v[j] * rstd * gg + bb;
        if (OUT_BF16) { u32x2 w; w.x = cvtpk(o[0], o[1]); w.y = cvtpk(o[2], o[3]); ((u32x2*)orow)[ci] = w; }
        else ((f32x4*)orow)[ci] = o;
    }
}

__device__ __forceinline__ void ln_store_h8(f32x4 (&v)[4], const float* g, const float* b, bf16_t* orow, unsigned char* orow8, int lane) {
    float s = 0.f;
#pragma unroll
    for (int j = 0; j < 4; ++j) s += (v[j].x + v[j].y) + (v[j].z + v[j].w);
    const float mean = wave_sum(s) * (1.f / D); float s2 = 0.f;
#pragma unroll
    for (int j = 0; j < 4; ++j) { v[j] = v[j] - mean; s2 += (v[j].x * v[j].x + v[j].y * v[j].y) + (v[j].z * v[j].z + v[j].w * v[j].w); }
    const float rstd = 1.f / sqrtf(wave_sum(s2) * (1.f / D) + 1e-5f);
    unsigned w8[4];
#pragma unroll
    for (int j = 0; j < 4; ++j) {
        const int ci = lane + 64 * j;
        const f32x4 gg = ((const f32x4*)g)[ci], bb = ((const f32x4*)b)[ci];
        const f32x4 o = v[j] * rstd * gg + bb;
        u32x2 w; w.x = cvtpk(o[0], o[1]); w.y = cvtpk(o[2], o[3]); ((u32x2*)orow)[ci] = w;
        int q = 0; q = __builtin_amdgcn_cvt_pk_fp8_f32(clamp8(o[0] * H8_SCALE), clamp8(o[1] * H8_SCALE), q, false); q = __builtin_amdgcn_cvt_pk_fp8_f32(clamp8(o[2] * H8_SCALE), clamp8(o[3] * H8_SCALE), q, true); w8[j] = (unsigned)q;
    }
#pragma unroll
    for (int j = 0; j < 4; ++j) ((unsigned*)orow8)[lane + 64 * j] = w8[j];
}

constexpr size_t KOFF = (size_t)NBATCH * 16 * SEQ * 64;
struct DChunk { int pat, d, r, l0, L; };
__device__ __forceinline__ DChunk dchunk(int ci) {
    DChunk c;
    if (ci < 16) { c.pat = 0; c.d = 1; c.r = 0; c.l0 = 128 * ci; c.L = 2048; }
    else if (ci < 32) { c.pat = 1; c.d = 4; c.r = (ci - 16) >> 2; c.l0 = 128 * ((ci - 16) & 3); c.L = 512; }
    else { c.pat = 2; c.d = 16; c.r = ci - 32; c.l0 = 0; c.L = 128; }
    return c;
}
__device__ __forceinline__ void dattn_stage(const bf16_t* base, const DChunk& c, LAS unsigned char* img, int wave, int lane) {
    int lb = c.l0 - 64 + (lane >> 3); asm volatile("" : "+v"(lb));
#pragma unroll
    for (int k = 0; k < 8; ++k) {
        const int inst = wave * 8 + k, rowl = 8 * (inst & 31) + (lane >> 3);
        int l = lb + 8 * (inst & 31); l = l < 0 ? 0 : (l > c.L - 1 ? c.L - 1 : l);
        const int t = c.d * l + c.r, chunk = (lane & 7) ^ ((inst < 32) ? ((rowl >> 1) & 7) : (((rowl >> 1) & 3) << 1));
        const bf16_t* src = base + ((inst < 32) ? KOFF : 2 * KOFF) + (size_t)t * 64 + chunk * 8;
        __builtin_amdgcn_global_load_lds((const unsigned*)src, (LAS unsigned*)(img + inst * 1024), 16, 0, 0);
    }
}
struct DOut { u32x2 w[4]; float lse; };
__device__ __forceinline__ void dattn_bias(f32x4 (&bias)[9], float slope_d_l2, int lane) {
    const int li = lane & 15, g = lane >> 4;
#pragma unroll
    for (int kt = 0; kt < 9; ++kt)
#pragma unroll
        for (int r = 0; r < 4; ++r) { const int rel = -64 + 16 * kt + 4 * g + r - li; bias[kt][r] = (rel >= -64 && rel <= 64) ? -slope_d_l2 * fabsf((float)rel) : -1e30f; }
}
__device__ __forceinline__ void dattn_qk(const DChunk& c, LAS const unsigned char* Kb, bf16x8 qf0, bf16x8 qf1, const f32x4 (&bias)[9], bf16x8 (&pf)[5], float& m_out, float& l_out, int wave, int lane) {
    const int g = lane >> 4;
    float sc[9][4];
    const bool edge = (c.l0 == 0) || (c.l0 + 192 > c.L);
#pragma unroll
    for (int kt = 0; kt < 9; ++kt) {
        const bf16x8 k0 = *(const LAS bf16x8*)(Kb + kt * 2048), k1 = *(const LAS bf16x8*)((LAS const unsigned char*)((unsigned)(size_t)Kb ^ 64u) + kt * 2048);
        f32x4 a = MFMA16(k0, qf0, bias[kt]); a = MFMA16(k1, qf1, a);
#pragma unroll
        for (int r = 0; r < 4; ++r) sc[kt][r] = a[r];
        if (kt % 3 == 2) __builtin_amdgcn_sched_barrier(0);
    }
    if (edge) {
#pragma unroll
        for (int kt = 0; kt < 9; ++kt)
#pragma unroll
            for (int r = 0; r < 4; ++r) { const int lk = c.l0 + 16 * wave - 64 + 16 * kt + 4 * g + r; sc[kt][r] = (lk >= 0 && lk < c.L) ? sc[kt][r] : -1e30f; }
    }
    float m = sc[0][0];
#pragma unroll
    for (int kt = 0; kt < 9; ++kt)
#pragma unroll
        for (int r = 0; r < 4; ++r) m = fmaxf(m, sc[kt][r]);
    m = fmaxf(m, __shfl_xor(m, 16)); m = fmaxf(m, __shfl_xor(m, 32));
    float l = 0.f;
#pragma unroll
    for (int kt = 0; kt < 9; ++kt)
#pragma unroll
        for (int r = 0; r < 4; ++r) { sc[kt][r] = __builtin_amdgcn_exp2f(sc[kt][r] - m); l += sc[kt][r]; }
    l += __shfl_xor(l, 16); l += __shfl_xor(l, 32);
#pragma unroll
    for (int ms = 0; ms < 5; ++ms) {
        u32x4 pw; pw.x = cvtpk(sc[2 * ms][0], sc[2 * ms][1]); pw.y = cvtpk(sc[2 * ms][2], sc[2 * ms][3]);
        if (ms < 4) { pw.z = cvtpk(sc[2 * ms + 1][0], sc[2 * ms + 1][1]); pw.w = cvtpk(sc[2 * ms + 1][2], sc[2 * ms + 1][3]); } else { pw.z = 0u; pw.w = 0u; }
        pf[ms] = __builtin_bit_cast(bf16x8, pw);
    }
    m_out = m; l_out = l;
}
__device__ __forceinline__ void dattn_pv(LAS const unsigned char* const (&Vb)[4], const bf16x8 (&pf)[5], float m, float l, LAS unsigned char* ost, LAS float* olse, int lane) {
    const int g = lane >> 4;
    f32x4 oacc[4];
#pragma unroll
    for (int et = 0; et < 4; ++et) oacc[et] = (f32x4){0.f, 0.f, 0.f, 0.f};
#pragma unroll
    for (int ms = 0; ms < 5; ++ms) {
#pragma unroll
        for (int et = 0; et < 4; ++et) {
            const s16x4 lo = vtr(Vb[et] + ms * 4096);
            s16x4 hi = (s16x4){0, 0, 0, 0};
            if (ms < 4) hi = vtr(Vb[et] + ms * 4096 + 2048);
            oacc[et] = MFMA16(cat8(lo, hi), pf[ms], oacc[et]);
        }
        __builtin_amdgcn_sched_barrier(0);
    }
    const float inv = 1.f / l;
    const int li = lane & 15;
    const float isc = inv * 16.f;
#pragma unroll
    for (int et = 0; et < 4; ++et) { int w = 0; w = __builtin_amdgcn_cvt_pk_fp8_f32(oacc[et][0] * isc, oacc[et][1] * isc, w, false); w = __builtin_amdgcn_cvt_pk_fp8_f32(oacc[et][2] * isc, oacc[et][3] * isc, w, true);
        *(LAS int*)(ost + li * 64 + ((et ^ (li & 3)) << 4) + g * 4) = w; }
    if (g == 0) olse[li] = (m + __builtin_amdgcn_logf(l)) * LN2;
}
__device__ __forceinline__ void dattn_store(const DChunk& c, LAS const unsigned char* ost, LAS const float* olse, size_t brow, int bh, bf16_t* P1, bf16_t* P2, bf16_t* P3, float* LSE, int wave, int lane) {
    unsigned char* P = (unsigned char*)(c.pat == 0 ? P1 : (c.pat == 1 ? P2 : P3));
    { const int r = lane >> 2, c4 = lane & 3; const int tq = c.d * (c.l0 + 16 * wave + r) + c.r;
      *(u32x4*)(P + ((size_t)bh * SEQ + tq) * 64 + c4 * 16) = *(const LAS u32x4*)(ost + r * 64 + ((c4 ^ (r & 3)) << 4)); }
    if (lane < 16) { const int tq = c.d * (c.l0 + 16 * wave + lane) + c.r; LSE[(size_t)c.pat * T * 16 + (size_t)bh * SEQ + tq] = olse[lane]; }
}
__device__ __forceinline__ void dattn_block(const bf16_t* QKV, bf16_t* YMIX, bf16_t* P2, bf16_t* P3, float* LSE, int bh, LAS unsigned char* lds, int wave, int lane) {
    asm volatile("" : "+v"(lane));
    const int b = bh >> 4, h = bh & 15, li = lane & 15, g = lane >> 4;
    const bf16_t* base = QKV + (size_t)bh * SEQ * 64;
    const float slope = exp2f(-0.5f * (float)(h + 1));
    DChunk cur = dchunk(0), prev = cur;
    bf16x8 qa0, qa1;
    { const int tq = cur.d * (cur.l0 + 16 * wave + li) + cur.r; qa0 = *(const bf16x8*)(base + (size_t)tq * 64 + 8 * g); qa1 = *(const bf16x8*)(base + (size_t)tq * 64 + 32 + 8 * g); }
    LAS unsigned char* ost = lds + STG_OFF + wave * 2048; LAS float* olse = (LAS float*)(lds + TAB_OFF) + wave * 16;
    f32x4 bias[9];
    dattn_bias(bias, slope * LOG2E, lane);
    const int q4 = li >> 2, p4 = li & 3, fv = ((2 * g + (q4 >> 1)) & 3) << 1;
    const unsigned kb0 = (unsigned)((16 * wave + li) * 128 + ((g ^ ((li >> 1) & 7)) << 4));
    unsigned vb0[4];
#pragma unroll
    for (int et = 0; et < 4; ++et) vb0[et] = (unsigned)(32768 + (16 * wave + 4 * g + q4) * 128 + (((2 * et) ^ fv) << 4) + ((p4 >> 1) << 4) + (p4 & 1) * 8);
    __syncthreads();
    dattn_stage(base, cur, lds, wave, lane);
    if (wave >= 4) __builtin_amdgcn_s_barrier();
#pragma unroll 1
    for (int ci = 0; ci < 48; ++ci) {
        asm volatile("s_waitcnt vmcnt(0)" ::: "memory");
        __syncthreads();
        bf16x8 qn0 = qa0, qn1 = qa1; DChunk nxt = cur;
        if (ci + 1 < 48) {
            nxt = dchunk(ci + 1);
            const int tq = nxt.d * (nxt.l0 + 16 * wave + li) + nxt.r; qn0 = *(const bf16x8*)(base + (size_t)tq * 64 + 8 * g); qn1 = *(const bf16x8*)(base + (size_t)tq * 64 + 32 + 8 * g);
        }
        if (ci > 0) dattn_store(prev, ost, olse, (size_t)b * SEQ, bh, YMIX, P2, P3, LSE, wave, lane);
        if (ci + 1 < 48) dattn_stage(base, nxt, lds + ((ci + 1) & 1) * 65536, wave, lane);
        if (ci == 16) dattn_bias(bias, slope * 4.f * LOG2E, lane); else if (ci == 32) dattn_bias(bias, slope * 16.f * LOG2E, lane);
        { LAS const unsigned char* ib = lds + (ci & 1) * 65536;
          LAS const unsigned char* const Vb[4] = {ib + vb0[0], ib + vb0[1], ib + vb0[2], ib + vb0[3]};
          bf16x8 pf[5]; float mrow, lrow;
          dattn_qk(cur, ib + kb0, qa0, qa1, bias, pf, mrow, lrow, wave, lane);
          asm volatile("s_waitcnt lgkmcnt(0)" ::: "memory"); __builtin_amdgcn_s_barrier(); asm volatile("" ::: "memory");
          dattn_pv(Vb, pf, mrow, lrow, ost, olse, lane); }
        qa0 = qn0; qa1 = qn1; prev = cur; cur = nxt;
    }
    if (wave < 4) __builtin_amdgcn_s_barrier();
    dattn_store(prev, ost, olse, (size_t)b * SEQ, bh, YMIX, P2, P3, LSE, wave, lane);
    asm volatile("s_waitcnt vmcnt(0)" ::: "memory");
    __syncthreads();
}

__device__ __forceinline__ void xattn_stage(const bf16_t* KVM, int b, int head, int quarter, LAS unsigned char* img, int wave, int lane) {
#pragma unroll
    for (int k = 0; k < 8; ++k) {
        const int inst = wave * 8 + k, row = 2 * (inst & 31) + (lane >> 5), slot = lane & 31;
        const int chunk = (inst < 32) ? (slot ^ (row & 15)) : (slot ^ ((row & 7) << 1));
        const bf16_t* src = KVM + (size_t)(b * 256 + quarter * 64 + row) * 2048 + ((inst < 32) ? 0 : 1024) + head * 256 + chunk * 8;
        __builtin_amdgcn_global_load_lds((const unsigned*)src, (LAS unsigned*)(img + inst * 1024), 16, 0, 0);
    }
}
__device__ __forceinline__ void xattn_phase(const bf16_t* QM, const bf16_t* KVM, bf16_t* XATT, LAS unsigned char* lds, int G, int vcu, int wave, int lane) {
    const int li = lane & 15, g = lane >> 4, q = li >> 2, p = li & 3;
    const int nblk = (1024 - vcu + G - 1) / G;
    if (nblk <= 0) return;
    const int niter = nblk * 4;
    bf16x8 qf[8]; f32x4 oacc[16]; float mrun = -1e30f, lrun = 0.f;
    __syncthreads();
    { const int L = vcu; xattn_stage(KVM, L >> 6, (L >> 4) & 3, 0, lds, wave, lane); }
    if (wave >= 4) __builtin_amdgcn_s_barrier();
#pragma unroll 1
    for (int it = 0; it < niter; ++it) {
        const int L = vcu + (it >> 2) * G, st = it & 3, b = L >> 6, head = (L >> 4) & 3, qblk = L & 15;
        const size_t trow = (size_t)b * SEQ + qblk * 128 + wave * 16 + li;
        if (st == 0) {
#pragma unroll
            for (int ks = 0; ks < 8; ++ks) qf[ks] = *(const bf16x8*)(QM + trow * 1024 + head * 256 + 32 * ks + 8 * g);
#pragma unroll
            for (int et = 0; et < 16; ++et) oacc[et] = (f32x4){0.f, 0.f, 0.f, 0.f};
            mrun = -1e30f; lrun = 0.f;
        }
        asm volatile("s_waitcnt vmcnt(0)" ::: "memory");
        __syncthreads();
        if (it + 1 < niter) { const int Ln = vcu + ((it + 1) >> 2) * G; xattn_stage(KVM, Ln >> 6, (Ln >> 4) & 3, (it + 1) & 3, lds + ((it + 1) & 1) * 65536, wave, lane); }
        LAS const unsigned char* Kimg = lds + (it & 1) * 65536; LAS const unsigned char* Vimg = Kimg + 32768;
        float sc[4][4];
#pragma unroll
        for (int kt = 0; kt < 4; ++kt) {
            const int rho = 16 * kt + li;
            f32x4 a = (f32x4){0.f, 0.f, 0.f, 0.f};
#pragma unroll
            for (int ks = 0; ks < 8; ++ks) a = MFMA16(*(const LAS bf16x8*)(Kimg + rho * 512 + (((4 * ks + g) ^ (rho & 15)) << 4)), qf[ks], a);
#pragma unroll
            for (int r = 0; r < 4; ++r) sc[kt][r] = a[r] * 0.0625f;
        }
        float m = sc[0][0];
#pragma unroll
        for (int kt = 0; kt < 4; ++kt)
#pragma unroll
            for (int r = 0; r < 4; ++r) m = fmaxf(m, sc[kt][r]);
        m = fmaxf(m, __shfl_xor(m, 16)); m = fmaxf(m, __shfl_xor(m, 32));
        const float mnew = fmaxf(mrun, m), alpha = __expf(mrun - mnew);
        float l = 0.f;
#pragma unroll
        for (int kt = 0; kt < 4; ++kt)
#pragma unroll
            for (int r = 0; r < 4; ++r) { sc[kt][r] = __expf(sc[kt][r] - mnew); l += sc[kt][r]; }
        l += __shfl_xor(l, 16); l += __shfl_xor(l, 32);
        lrun = lrun * alpha + l; mrun = mnew;
#pragma unroll
        for (int et = 0; et < 16; ++et) oacc[et] = oacc[et] * alpha;
        bf16x8 pf[2];
#pragma unroll
        for (int ms = 0; ms < 2; ++ms) { u32x4 pw; pw.x = cvtpk(sc[2 * ms][0], sc[2 * ms][1]); pw.y = cvtpk(sc[2 * ms][2], sc[2 * ms][3]); pw.z = cvtpk(sc[2 * ms + 1][0], sc[2 * ms + 1][1]); pw.w = cvtpk(sc[2 * ms + 1][2], sc[2 * ms + 1][3]); pf[ms] = __builtin_bit_cast(bf16x8, pw); }
        asm volatile("s_waitcnt lgkmcnt(0)" ::: "memory"); __builtin_amdgcn_s_barrier(); asm volatile("" ::: "memory");
#pragma unroll
        for (int ms = 0; ms < 2; ++ms) {
            const int rlo = 32 * ms + 4 * g + q, rhi = rlo + 16, flo = (rlo & 7) << 1, fhi = (rhi & 7) << 1;
#pragma unroll
            for (int et = 0; et < 16; ++et) {
                const int chunk = 2 * et + (p >> 1), sub = (p & 1) * 8;
                const s16x4 lo = vtr(Vimg + rlo * 512 + ((chunk ^ flo) << 4) + sub), hi = vtr(Vimg + rhi * 512 + ((chunk ^ fhi) << 4) + sub);
                oacc[et] = MFMA16(cat8(lo, hi), pf[ms], oacc[et]);
                if ((et & 3) == 3) __builtin_amdgcn_sched_barrier(0);
            }
        }
        if (st == 3) {
            const float inv = 1.f / lrun;
#pragma unroll
            for (int et = 0; et < 16; ++et) { u32x2 w; w.x = cvtpk(oacc[et][0] * inv, oacc[et][1] * inv); w.y = cvtpk(oacc[et][2] * inv, oacc[et][3] * inv); *(u32x2*)(XATT + trow * 1024 + head * 256 + 16 * et + 4 * g) = w; }
        }
    }
    if (wave < 4) __builtin_amdgcn_s_barrier();
    asm volatile("s_waitcnt vmcnt(0)" ::: "memory");
    __syncthreads();
}

#define XB_TMO      128
#define XB_XCNT(j)  (256  + 64 * (j))
#define XB_XSUB(j)  (1280 + 64 * (j))
#define XB_XGEN(j)  (2304 + 64 * (j))
#define XB_TOP      3328
#define XB_TOPGEN   3392
#define XCD_BAR_WORDS 3456
#define XB_SPIN_CAP (1u << 18)
__device__ __forceinline__ unsigned xb_ld(unsigned* p)              { return __hip_atomic_load(p, __ATOMIC_RELAXED, __HIP_MEMORY_SCOPE_AGENT); }
__device__ __forceinline__ unsigned xb_add(unsigned* p, unsigned v) { return __hip_atomic_fetch_add(p, v, __ATOMIC_RELAXED, __HIP_MEMORY_SCOPE_AGENT); }
__device__ __forceinline__ unsigned xb_xcc_id() { return (unsigned)__builtin_amdgcn_s_getreg((3 << 11) | 20) & 0xFu; }
#define XB_SPIN(cond, bar) do { unsigned _sp = 0; while (cond) { __builtin_amdgcn_s_sleep(1); \
    if ((++_sp & 255u) == 0u) { if (xb_ld(&(bar)[XB_TMO])) break; if (_sp > XB_SPIN_CAP) { atomicAdd(&(bar)[XB_TMO], 1u); break; } } } } while (0)
struct XcdBarrier { unsigned* bar; unsigned x; volatile LAS unsigned* st; };
__device__ __forceinline__ XcdBarrier xcd_barrier_post(unsigned* bar, volatile LAS unsigned* st, int wv) {
    XcdBarrier b; b.bar = bar; b.x = xb_xcc_id(); b.st = st;
    if (wv == 0 && lane_id() == 0) (void)xb_add(&bar[XB_XCNT(b.x)], 1u);
    return b;
}
__device__ __forceinline__ void xcd_barrier_complete(unsigned* bar, unsigned x, unsigned& nloc, unsigned& nx) {
    const unsigned G = gridDim.x * gridDim.y * gridDim.z;
    unsigned sum, cnt, mine, sp = 0u;
    for (;;) {
        sum = 0u; cnt = 0u; mine = 0u;
#pragma unroll
        for (unsigned j = 0; j < 16; ++j) { const unsigned c = xb_ld(&bar[XB_XCNT(j)]); sum += c; cnt += (c > 0u) ? 1u : 0u; mine = (j == x) ? c : mine; }
        if (sum == G) break;
        __builtin_amdgcn_s_sleep(1);
        if ((++sp & 255u) == 0u) { if (xb_ld(&bar[XB_TMO])) break; if (sp > XB_SPIN_CAP) { atomicAdd(&bar[XB_TMO], 1u); break; } }
    }
    nloc = mine > 0u ? mine : 1u; nx = cnt > 0u ? cnt : 1u;
}
__device__ __forceinline__ void xcd_barrier(const XcdBarrier& b, int wv) {
    asm volatile("s_waitcnt vmcnt(0)" ::: "memory");
    __syncthreads();
    if (wv == 0 && lane_id() == 0) {
        unsigned* bar = b.bar;
        __builtin_amdgcn_s_waitcnt(0);
        unsigned nloc = b.st[0], nx = b.st[1];
        if (nloc == 0u) { xcd_barrier_complete(bar, b.x, nloc, nx); b.st[0] = nloc; b.st[1] = nx; }
        const unsigned old = xb_add(&bar[XB_XSUB(b.x)], 1u);
        const unsigned gen = old / nloc;
        if (old + 1u == (gen + 1u) * nloc) {
            __builtin_amdgcn_fence(__ATOMIC_RELEASE, "agent");
            asm volatile("s_waitcnt vmcnt(0)" ::: "memory");
            const unsigned og = xb_add(&bar[XB_TOP], 1u);
            const unsigned tg = og / nx;
            if (og + 1u == (tg + 1u) * nx) xb_add(&bar[XB_TOPGEN], 1u);
            else XB_SPIN(xb_ld(&bar[XB_TOPGEN]) == tg, bar);
            __builtin_amdgcn_fence(__ATOMIC_ACQUIRE, "agent");
            xb_add(&bar[XB_XGEN(b.x)], 1u);
            asm volatile("s_waitcnt vmcnt(0)" ::: "memory");
        } else {
            XB_SPIN(xb_ld(&bar[XB_XGEN(b.x)]) == gen, bar);
            __builtin_amdgcn_fence(__ATOMIC_ACQUIRE, "agent");
            asm volatile("s_waitcnt vmcnt(0)" ::: "memory");
        }
    }
    __syncthreads();
}

template <int PH>
__device__ __forceinline__ void run_phase(LAS unsigned char* lds, const Args& a_in, int G, int bx, int vcu, int wv) {
    constexpr int ph = (PH == 19) ? 18 : ((PH == 20) ? 13 : ((PH == 21) ? 17 : PH));
    const int NGW = G * 8, NGT = G * 512;
    typedef const __attribute__((address_space(4))) Args* KArgs;
    {
#if defined(__HIP_DEVICE_COMPILE__)
        KArgs ap = (KArgs)__builtin_amdgcn_kernarg_segment_ptr();
        asm volatile("" : "+s"(ap));
#else
        const Args* ap = &a_in;
#endif
        unsigned char* ws = ap->ws;
        int tid = wv * 64 + lane_id(); asm volatile("" : "+v"(tid));
        const int lane = tid & 63, wave = __builtin_amdgcn_readfirstlane(tid >> 6);
        const int gw = vcu * 8 + wave, gt = bx * 512 + tid;
        bf16_t* HB = (bf16_t*)(ws + WS_HB);
        int* counts = (int*)(ws + WS_CTL) + CW_COUNTS + ((PH == 20) ? 512 : 0);
        constexpr bool is_gemm = (ph == 1) || (ph == 6) || (ph == 8) || (ph == 10) || (ph == 12) || (ph == 15) || (ph == 17);
        if (is_gemm && PH_EN(1)) {
            if (ph == 15 || ph == 17) {
                LAS int* CN = (LAS int*)(lds + TAB_OFF); LAS int* TP = CN + 256; LAS int* SB = CN + 256 + 260;
                if (wave == 0) {
                    int c[4], tl[4]; int ts = 0, ss = 0;
#pragma unroll
                    for (int i = 0; i < 4; ++i) { c[i] = ld_agent(counts + 4 * lane + i); tl[i] = (c[i] + 255) >> 8; ts += tl[i]; ss += c[i]; CN[4 * lane + i] = c[i]; }
                    int xt = ts, xs = ss;
#pragma unroll
                    for (int o = 1; o < 64; o <<= 1) { const int yt = __shfl_up(xt, o), ys = __shfl_up(xs, o); if (lane >= o) { xt += yt; xs += ys; } }
                    int et = xt - ts, es = xs - ss;
#pragma unroll
                    for (int i = 0; i < 4; ++i) { TP[4 * lane + i] = et; SB[4 * lane + i] = es; et += tl[i]; es += c[i]; }
                    if (lane == 63) { TP[256] = et; SB[256] = es; }
                }
                __syncthreads();
            }
#pragma unroll
            for (int sub = 0; sub < 3; ++sub) {
                pg8::GJob j; int var = -1;
                j.M = T; j.N = 1024; j.K = 1024; j.ldo = 1024; j.alpha = DN_ALPHA;
                j.A = HB; j.Bt = nullptr; j.o0 = nullptr; j.o1 = nullptr; j.o2 = nullptr; j.o3 = nullptr; j.res = HB; j.tok = (const int*)(ws + WS_TOK); j.xA = nullptr; j.xB = nullptr; j.xO = nullptr;
                int u_lo = 0, u_hi = 1 << 30;
                if (ph == 1 && JP(1)) {
                    if (sub == 1) { __syncthreads(); convert_expert_weights(ap->in[24], ap->in[25], ap->in[26], ws, lds, vcu, NGW, wv); __syncthreads(); u_lo = bx % 13; } else u_hi = bx % 13;
                    if (sub <= 1) { var = 0; j.Bt = (const bf16_t*)(ws + WS_WIN); j.N = 6400; j.o0 = ws + WS_Z; j.o1 = ws + WS_XBC; j.o2 = ws + WS_QKV; j.o3 = ws + WS_DTRAW;
                                    j.xA = (const bf16_t*)(ws + WS_MEMB); j.xB = (const bf16_t*)(ws + WS_WK); j.xO = ws + WS_KM; }
                } else if (ph == 6 && JP(6)) {
                    if (sub == 0) { var = 2; j.A = (const bf16_t*)(ws + WS_YMIX); j.K = 2048; j.Bt = (const bf16_t*)(ws + WS_WOUT); j.o0 = ap->out; }
                } else if (ph == 8 && JP(8)) {
                    if (sub == 0) { var = 1; j.Bt = (const bf16_t*)(ws + WS_WQ); j.o0 = ws + WS_QM; }
                } else if (ph == 10 && JP(10)) {
                    if (sub == 0) { var = 2; j.A = (const bf16_t*)(ws + WS_XATT); j.Bt = (const bf16_t*)(ws + WS_WO); j.o0 = ap->out; }
                } else if (ph == 12 && JP(12)) {
                    if (sub == 0) { var = 3; j.Bt = (const bf16_t*)(ws + WS_WR); j.N = 256; j.ldo = 256; j.o0 = ws + WS_LOGITS; }
                    else if (sub == 1) { var = 4; j.Bt = (const bf16_t*)(ws + WS_WSGU); j.N = 512; j.o0 = ws + WS_HIDS; }
                } else if (ph == 15 && JP(15)) {
                    if (sub == 0) { var = 5; j.A = (const bf16_t*)(ws + WS_HB8); j.K = 512; j.Bt = (const bf16_t*)(ws + WS_WGU); j.o0 = ws + WS_HID; }
                    else if (sub == 1) { var = 2; j.A = (const bf16_t*)(ws + WS_HIDS); j.K = 256; j.Bt = (const bf16_t*)(ws + WS_WSD); j.o0 = ws + WS_PRE3; }
                } else if (ph == 17 && JP(17)) {
                    if (sub == 0) { var = 6; j.A = (const bf16_t*)(ws + WS_HID); j.K = 128; j.Bt = (const bf16_t*)(ws + WS_WD); j.o0 = ws + WS_YROWS; if (PH == 21) j.ldo = 0; }
                }
                if (var == 0) {
                    pg8::gemm_phase<0, pg8::M_PROJ, 1>(lds, j, G, bx, vcu, wv, u_lo, u_hi);
                }
                else if (var == 1) pg8::gemm_phase<0, pg8::M_BF16, 1>(lds, j, G, bx, vcu, wv);
                else if (var == 2) pg8::gemm_phase<0, pg8::M_RESBF16, 1>(lds, j, G, bx, vcu, wv);
                else if (var == 3) pg8::gemm_phase<0, pg8::M_F32, 0>(lds, j, G, bx, vcu, wv);
                else if (var == 4) pg8::gemm_phase<0, pg8::M_GATEUP, 1>(lds, j, G, bx, vcu, wv);
                else if (var == 5) pg8::gemm_phase<1, pg8::M_GATEUP8, 1, 1>(lds, j, G, bx, vcu, wv);
                else if (var == 6) pg8::gemm_phase<2, pg8::M_FP8ROWS, 1, 2>(lds, j, G, bx, vcu, wv);
            }
        } else if (ph == 0 && PH_EN(0)) {
            LAS float* scr = (LAS float*)(lds + wave * (64 * 65 * 4));
            int off = 0;
            TrJob j; j.map = 0; j.p0 = 0;
            j.W = ap->in[4]; j.WT = (bf16_t*)(ws + WS_WIN); j.ldw = 6176; j.ncols = 6176; j.K = 1024; j.ldt = 1024; j.map = 1; tr_run<true>(j, 1, 0, 0, scr, gw, NGW, lane, off);
            j.map = 0;
            j.W = ap->in[13]; j.WT = (bf16_t*)(ws + WS_WOUT); j.ldw = 1024; j.ncols = 1024; j.K = 2048; j.ldt = 2048; tr_run(j, 1, 0, 0, scr, gw, NGW, lane, off);
            j.K = 1024; j.ldt = 1024;
            j.W = ap->in[16]; j.WT = (bf16_t*)(ws + WS_WQ); tr_run(j, 1, 0, 0, scr, gw, NGW, lane, off);
            j.W = ap->in[17]; j.WT = (bf16_t*)(ws + WS_WK); tr_run(j, 1, 0, 0, scr, gw, NGW, lane, off);
            j.W = ap->in[18]; j.WT = (bf16_t*)(ws + WS_WV); tr_run(j, 1, 0, 0, scr, gw, NGW, lane, off);
            j.W = ap->in[19]; j.WT = (bf16_t*)(ws + WS_WO); tr_run(j, 1, 0, 0, scr, gw, NGW, lane, off);
            j.W = ap->in[22]; j.WT = (bf16_t*)(ws + WS_WR); j.ldw = 256; j.ncols = 256; tr_run(j, 1, 0, 0, scr, gw, NGW, lane, off);
            j.map = 2;
            j.W = ap->in[27]; j.WT = (bf16_t*)(ws + WS_WSGU); j.p0 = 0; tr_run(j, 1, 0, 0, scr, gw, NGW, lane, off);
            j.W = ap->in[28]; j.p0 = 32; tr_run(j, 1, 0, 0, scr, gw, NGW, lane, off);
            j.map = 0; j.p0 = 0;
            j.W = ap->in[29]; j.WT = (bf16_t*)(ws + WS_WSD); j.ldw = 1024; j.ncols = 1024; j.K = 256; j.ldt = 256; tr_run(j, 1, 0, 0, scr, gw, NGW, lane, off);
            { u32x4* z = (u32x4*)((bf16_t*)(ws + WS_WIN) + (size_t)6176 * 1024); const int n16 = 224 * 1024 * 2 / 16; for (int i = gt; i < n16; i += NGT) z[i] = (u32x4){0u, 0u, 0u, 0u}; }
            { const f32x4* s = (const f32x4*)ap->in[1]; u32x2* dd = (u32x2*)(ws + WS_MEMB); const int n4 = 4096 * 1024 / 4;
#pragma unroll 8
              for (int i = gt; i < n4; i += NGT) { const f32x4 v = s[i]; u32x2 w; w.x = cvtpk(v[0], v[1]); w.y = cvtpk(v[2], v[3]); dd[i] = w; } }
            for (int m = gw; m < T; m += NGW) {
                const f32x4* xr = (const f32x4*)(ap->in[0] + (size_t)m * D) + lane; f32x4 v[4];
#pragma unroll
                for (int jx = 0; jx < 4; ++jx) v[jx] = xr[64 * jx];
                ln_store<true>(v, ap->in[2], ap->in[3], HB + (size_t)m * D, lane);
            }
        } else if (ph == 2 && PH_EN(2)) {
            {
                const bf16_t* XBC = (const bf16_t*)(ws + WS_XBC); bf16_t* XBCA = (bf16_t*)((unsigned char*)ap->out);
                const int c8 = gt & 255; float w[5][8], bs[8];
#pragma unroll
                for (int k = 0; k < 5; ++k)
#pragma unroll
                    for (int jx = 0; jx < 8; ++jx) w[k][jx] = ap->in[5][k * 2048 + c8 * 8 + jx];
#pragma unroll
                for (int jx = 0; jx < 8; ++jx) bs[jx] = ap->in[6][c8 * 8 + jx];
                {
                    const int tb = (bx * 2 + (tid >> 8)) * 64;
                    const int s0 = tb & (SEQ - 1);
                    u32x4 rw[12];
#pragma unroll
                    for (int k = 0; k < 4; ++k) { const int ss = s0 + k - 2; rw[8 + k] = (ss >= 0 && ss < SEQ) ? *(const u32x4*)(XBC + (size_t)(tb + k - 2) * 2048 + c8 * 8) : (u32x4){0u, 0u, 0u, 0u}; }
#pragma unroll 1
                    for (int i0 = 0; i0 < 64; i0 += 8) {
#pragma unroll
                        for (int k = 0; k < 4; ++k) rw[k] = rw[8 + k];
#pragma unroll
                        for (int k = 0; k < 8; ++k) { const int ss = s0 + i0 + 2 + k; rw[4 + k] = (ss < SEQ) ? *(const u32x4*)(XBC + (size_t)(tb + i0 + 2 + k) * 2048 + c8 * 8) : (u32x4){0u, 0u, 0u, 0u}; }
#pragma unroll
                        for (int i = 0; i < 8; ++i) {
                            float acc[8];
#pragma unroll
                            for (int jx = 0; jx < 8; ++jx) acc[jx] = bs[jx];
#pragma unroll
                            for (int k = 0; k < 5; ++k) { const u32x4 v = rw[i + k];
                                acc[0] += w[k][0] * bflo(v.x); acc[1] += w[k][1] * bfhi(v.x); acc[2] += w[k][2] * bflo(v.y); acc[3] += w[k][3] * bfhi(v.y);
                                acc[4] += w[k][4] * bflo(v.z); acc[5] += w[k][5] * bfhi(v.z); acc[6] += w[k][6] * bflo(v.w); acc[7] += w[k][7] * bfhi(v.w); }
                            u32x4 o; o.x = cvtpk(siluf(acc[0]), siluf(acc[1])); o.y = cvtpk(siluf(acc[2]), siluf(acc[3])); o.z = cvtpk(siluf(acc[4]), siluf(acc[5])); o.w = cvtpk(siluf(acc[6]), siluf(acc[7]));
                            *(u32x4*)(XBCA + (size_t)(tb + i0 + i) * 2048 + c8 * 8) = o;
                        }
                    }
                }
                const float* DTRAW = (const float*)(ws + WS_DTRAW); float* DTF = (float*)(ws + WS_DTF); float* DTB = (float*)(ws + WS_DTB);
                for (int i = gt; i < T * 16; i += NGT) { const int t = i >> 4, h = i & 15;
                    const float xf = DTRAW[t * 32 + h] + ap->in[7][h], xb = DTRAW[t * 32 + 16 + h] + ap->in[8][h];
                    const int o = (((t >> 7) * 16) + h) * 128 + (t & 127);
                    DTF[o] = fmaxf(xf, 0.f) + log1pf(__expf(-fabsf(xf))); DTB[o] = fmaxf(xb, 0.f) + log1pf(__expf(-fabsf(xb))); }
            }
#ifdef DUP_DATTN
            for (int bh = vcu; bh < 256; bh += G)
                dattn_block((const bf16_t*)(ws + WS_QKV), (bf16_t*)(ws + WS_ATTP1), (bf16_t*)(ws + WS_ATTP2), (bf16_t*)(ws + WS_ATTP3), (float*)(ws + WS_LSE), bh, lds, wave, lane);
#endif
            for (int bh = vcu; bh < 256; bh += G)
                dattn_block((const bf16_t*)(ws + WS_QKV), (bf16_t*)(ws + WS_ATTP1), (bf16_t*)(ws + WS_ATTP2), (bf16_t*)(ws + WS_ATTP3), (float*)(ws + WS_LSE), bh, lds, wave, lane);
        } else if (ph == 3 && PH_EN(3)) {
            const bf16_t* XBCA = (const bf16_t*)((unsigned char*)ap->out);
            const float* DTF = (const float*)(ws + WS_DTF); const float* DTB = (const float*)(ws + WS_DTB);
            float* ECSF = (float*)(ws + WS_ECSF); float* ECSB = (float*)(ws + WS_ECSB); float* DEC = (float*)(ws + WS_DEC);
            bf16_t* YSSD = (bf16_t*)(ws + WS_YSSD); bf16_t* STATES = (bf16_t*)(ws + WS_STATES);
            constexpr int BM_OFF = 0, BM_P = 288, XH_OFF = 36864, XH_P = 160, XHF_OFF = XH_OFF + 20480, XHB_OFF = XHF_OFF + 20480, ARR_OFF = XHB_OFF + 20480,
                          ST_OFF = ARR_OFF + 4 * 3072, ST_P = 272, YS_OFF = XHF_OFF, YS_P = 272;
            const int li = lane & 15, g4 = lane >> 4;
            for (int L = vcu; L < 1024; L += G) {
                const int b = L >> 6, c = (L >> 2) & 15, grp = L & 3;
                const size_t t0 = (size_t)b * SEQ + c * 128;
                __syncthreads();
#pragma unroll
                for (int ps = 0; ps < 4; ++ps) { const int sI = ps * 32 + (tid >> 4), ch = tid & 15;
                    *(LAS u32x4*)(lds + BM_OFF + sI * BM_P + ch * 16) = *(const u32x4*)(XBCA + (t0 + sI) * 2048 + 1024 + grp * 128 + ch * 8); }
                bf16x8 cf[4];
#pragma unroll
                for (int ks = 0; ks < 4; ++ks) cf[ks] = *(const bf16x8*)(XBCA + (t0 + 16 * wave + li) * 2048 + 1536 + grp * 128 + 32 * ks + 8 * g4);
                if (wave < 4) {
                        const int hh = wave, h = grp * 4 + hh; const size_t hc = ((size_t)(b * 16 + c) * 16 + h) * 128;
                        LAS float* csf = (LAS float*)(lds + ARR_OFF) + hh * 768; LAS float* csb = csf + 128; LAS float* dtfa = csf + 256; LAS float* dtba = csf + 384; LAS float* wfa = csf + 512; LAS float* wba = csf + 640;
                        const float af = -__expf(ap->in[9][h]), ab = -__expf(ap->in[10][h]);
                        const int s0 = 2 * lane;
                        const f32x2 dfv = *(const f32x2*)(DTF + hc + s0), dbv = *(const f32x2*)(DTB + hc + s0);
                        const float df0 = dfv.x, df1 = dfv.y, db0 = dbv.x, db1 = dbv.y;
                        const float pf_ = (df0 + df1) * af, pb_ = (db0 + db1) * ab;
                        float xf = pf_, xb = pb_;
#pragma unroll
                        for (int o = 1; o < 64; o <<= 1) { const float yf = __shfl_up(xf, o), yb = __shfl_up(xb, o); if (lane >= o) { xf += yf; xb += yb; } }
                        const float totf = __shfl(xf, 63), totb = __shfl(xb, 63);
                        const float ef = xf - pf_, eb = xb - pb_;
                        const float cf0 = ef + df0 * af, cf1 = ef + pf_;
                        const float cb0 = totb - eb, cb1 = totb - eb - db0 * ab;
                        csf[s0] = cf0; csf[s0 + 1] = cf1; csb[s0] = cb0; csb[s0 + 1] = cb1; dtfa[s0] = df0; dtfa[s0 + 1] = df1; dtba[s0] = db0; dtba[s0 + 1] = db1;
                        wfa[s0] = df0 * __expf(totf - cf0); wfa[s0 + 1] = df1 * __expf(totf - cf1); wba[s0] = db0 * __expf(totb - cb0); wba[s0 + 1] = db1 * __expf(totb - cb1);
                        *(f32x2*)(ECSF + hc + s0) = (f32x2){__expf(cf0), __expf(cf1)}; *(f32x2*)(ECSB + hc + s0) = (f32x2){__expf(cb0), __expf(cb1)};
                        if (lane == 0) { DEC[((b * 16 + c) * 16 + h) * 2 + 0] = __expf(totf); DEC[((b * 16 + c) * 16 + h) * 2 + 1] = __expf(totb); }
                    }
                __syncthreads();
                f32x4 cbt[8];
#pragma unroll
                for (int st = 0; st < 8; ++st) { f32x4 acc = (f32x4){0.f, 0.f, 0.f, 0.f};
#pragma unroll
                    for (int ks = 0; ks < 4; ++ks) acc = MFMA16(*(const LAS bf16x8*)(lds + BM_OFF + (16 * st + li) * BM_P + (32 * ks + 8 * g4) * 2), cf[ks], acc);
                    cbt[st] = acc; }
                u32x4 xpre[2];
#pragma unroll
                for (int ps = 0; ps < 2; ++ps) { const int id = ps * 512 + tid, sI = id >> 3, ch = id & 7; xpre[ps] = *(const u32x4*)(XBCA + (t0 + sI) * 2048 + grp * 256 + ch * 8); }
                for (int hh = 0; hh < 4; ++hh) {
                    const int h = grp * 4 + hh;
                    const size_t hc = ((size_t)(b * 16 + c) * 16 + h) * 128;
                    LAS float* csf = (LAS float*)(lds + ARR_OFF) + hh * 768; LAS float* csb = csf + 128; LAS float* dtfa = csf + 256; LAS float* dtba = csf + 384; LAS float* wfa = csf + 512; LAS float* wba = csf + 640;
                    __syncthreads();
#pragma unroll
                    for (int ps = 0; ps < 2; ++ps) { const int id = ps * 512 + tid, sI = id >> 3, ch = id & 7;
                        *(LAS u32x4*)(lds + XH_OFF + sI * XH_P + ch * 16) = xpre[ps]; }
                    __syncthreads();
                    if (hh < 3) {
#pragma unroll
                        for (int ps = 0; ps < 2; ++ps) { const int id = ps * 512 + tid, sI = id >> 3, ch = id & 7; xpre[ps] = *(const u32x4*)(XBCA + (t0 + sI) * 2048 + (h + 1) * 64 + ch * 8); }
                    }
#pragma unroll
                    for (int ps = 0; ps < 2; ++ps) { const int id = ps * 512 + tid, sI = id >> 3, ch = id & 7;
                        const u32x4 v = *(const LAS u32x4*)(lds + XH_OFF + sI * XH_P + ch * 16); const float wf = wfa[sI], wb = wba[sI];
                        u32x4 of, ob;
                        of.x = cvtpk(bflo(v.x) * wf, bfhi(v.x) * wf); of.y = cvtpk(bflo(v.y) * wf, bfhi(v.y) * wf); of.z = cvtpk(bflo(v.z) * wf, bfhi(v.z) * wf); of.w = cvtpk(bflo(v.w) * wf, bfhi(v.w) * wf);
                        ob.x = cvtpk(bflo(v.x) * wb, bfhi(v.x) * wb); ob.y = cvtpk(bflo(v.y) * wb, bfhi(v.y) * wb); ob.z = cvtpk(bflo(v.z) * wb, bfhi(v.z) * wb); ob.w = cvtpk(bflo(v.w) * wb, bfhi(v.w) * wb);
                        *(LAS u32x4*)(lds + XHF_OFF + sI * XH_P + ch * 16) = of; *(LAS u32x4*)(lds + XHB_OFF + sI * XH_P + ch * 16) = ob; }
                    __syncthreads();
                    const int q = li >> 2, p = li & 3;
#pragma unroll 1
                    for (int k = 0; k < 8; ++k) {
                        const int dir = wave >> 2, ntile = (wave & 3) * 2 + (k >> 2), pt = k & 3;
                        const int xoff = dir ? XHB_OFF : XHF_OFF;
                        f32x4 acc = (f32x4){0.f, 0.f, 0.f, 0.f};
#pragma unroll
                        for (int ks = 0; ks < 4; ++ks) {
                            const int rb = 32 * ks + 8 * g4 + q;
                            const s16x4 alo = vtr(lds + BM_OFF + rb * BM_P + (16 * ntile + 4 * p) * 2), ahi = vtr(lds + BM_OFF + (rb + 4) * BM_P + (16 * ntile + 4 * p) * 2);
                            const s16x4 blo = vtr(lds + xoff + rb * XH_P + (16 * pt + 4 * p) * 2), bhi = vtr(lds + xoff + (rb + 4) * XH_P + (16 * pt + 4 * p) * 2);
                            acc = MFMA16(cat8(alo, ahi), cat8(blo, bhi), acc);
                        }
                        u32x2 w; w.x = cvtpk(acc[0], acc[1]); w.y = cvtpk(acc[2], acc[3]);
                        *(LAS u32x2*)(lds + ST_OFF + (dir * 64 + 16 * pt + li) * ST_P + (16 * ntile + 4 * g4) * 2) = w;
                    }
                    __syncthreads();
                    {
                        const int tl = 16 * wave + li; const float cft = csf[tl], cbt_t = csb[tl];
                        f32x4 yacc[4];
#pragma unroll
                        for (int pt = 0; pt < 4; ++pt) yacc[pt] = (f32x4){0.f, 0.f, 0.f, 0.f};
#pragma unroll
                        for (int k2 = 0; k2 < 4; ++k2) {
                            float mv[8];
#pragma unroll
                            for (int half = 0; half < 2; ++half) {
                                const int st = 2 * k2 + half, sb = 16 * st + 4 * g4;
                                const f32x4 c4f = *(const LAS f32x4*)(csf + sb), c4b = *(const LAS f32x4*)(csb + sb), d4f = *(const LAS f32x4*)(dtfa + sb), d4b = *(const LAS f32x4*)(dtba + sb);
#pragma unroll
                                for (int r = 0; r < 4; ++r) { const int sI = sb + r;
                                    const float lf = (sI <= tl) ? __expf(cft - c4f[r]) * d4f[r] : 0.f, lb = (sI >= tl) ? __expf(cbt_t - c4b[r]) * d4b[r] : 0.f;
                                    mv[half * 4 + r] = cbt[st][r] * (lf + lb); }
                            }
                            u32x4 aw; aw.x = cvtpk(mv[0], mv[1]); aw.y = cvtpk(mv[2], mv[3]); aw.z = cvtpk(mv[4], mv[5]); aw.w = cvtpk(mv[6], mv[7]);
                            const bf16x8 af8 = __builtin_bit_cast(bf16x8, aw);
#pragma unroll
                            for (int pt = 0; pt < 4; ++pt) {
                                const s16x4 lo = vtr(lds + XH_OFF + (32 * k2 + 4 * g4 + q) * XH_P + (16 * pt + 4 * p) * 2), hi = vtr(lds + XH_OFF + (32 * k2 + 16 + 4 * g4 + q) * XH_P + (16 * pt + 4 * p) * 2);
                                yacc[pt] = MFMA16(cat8(lo, hi), af8, yacc[pt]);
                            }
                        }
#pragma unroll
                        for (int pt = 0; pt < 4; ++pt) *(LAS f32x4*)(lds + YS_OFF + tl * YS_P + (16 * pt + 4 * g4) * 4) = yacc[pt];
                    }
#pragma unroll
                    for (int ps = 0; ps < 4; ++ps) { const int id = ps * 512 + tid, dir = id >> 10, fc = id & 1023, row = 16 * (fc >> 8) + (fc & 15), n0 = 32 * ((fc >> 6) & 3) + 8 * ((fc >> 4) & 3);
                        *(u32x4*)(STATES + ((hc / 128) * 2 + dir) * 8192 + fc * 8) = *(const LAS u32x4*)(lds + ST_OFF + (dir * 64 + row) * ST_P + n0 * 2); }
                    __syncthreads();
                    const float dsk = ap->in[11][h];
#pragma unroll
                    for (int ps = 0; ps < 2; ++ps) { const int f2 = ps * 512 + tid;
                        u32x4 ow;
#pragma unroll
                        for (int e = 0; e < 2; ++e) { const int fc = 2 * f2 + e, row = 16 * (fc >> 8) + (fc & 15), p0 = 16 * ((fc >> 6) & 3) + 4 * ((fc >> 4) & 3);
                            f32x4 o = *(const LAS f32x4*)(lds + YS_OFF + row * YS_P + p0 * 4);
                            const u32x2 xw = *(const LAS u32x2*)(lds + XH_OFF + row * XH_P + p0 * 2);
                            o[0] += dsk * bflo(xw.x); o[1] += dsk * bfhi(xw.x); o[2] += dsk * bflo(xw.y); o[3] += dsk * bfhi(xw.y);
                            if (e == 0) { ow.x = cvtpk(o[0], o[1]); ow.y = cvtpk(o[2], o[3]); } else { ow.z = cvtpk(o[0], o[1]); ow.w = cvtpk(o[2], o[3]); } }
                        *(u32x4*)(YSSD + hc * 64 + (size_t)f2 * 8) = ow; }
                }
            }
        } else if (ph == 4 && PH_EN(4)) {
            bf16_t* STATES = (bf16_t*)(ws + WS_STATES); const float* DEC = (const float*)(ws + WS_DEC);
            for (int task = gt; task < 16 * 16 * 2 * 64 * 16; task += NGT) {
                const int n8 = task & 15, p = (task >> 4) & 63, dir = (task >> 10) & 1, h = (task >> 11) & 15, b = task >> 15;
                float hs[8];
#pragma unroll
                for (int i = 0; i < 8; ++i) hs[i] = 0.f;
#pragma unroll
                for (int step = 0; step < 16; ++step) {
                    const int c = dir ? 15 - step : step;
                    u32x4* ptr = (u32x4*)(STATES + ((((size_t)(b * 16 + c) * 16 + h) * 2 + dir) * 64 + p) * 128 + n8 * 8);
                    const u32x4 s = *ptr; const float dc = DEC[((b * 16 + c) * 16 + h) * 2 + dir];
                    u32x4 o; o.x = cvtpk(hs[0], hs[1]); o.y = cvtpk(hs[2], hs[3]); o.z = cvtpk(hs[4], hs[5]); o.w = cvtpk(hs[6], hs[7]); *ptr = o;
                    hs[0] = hs[0] * dc + bflo(s.x); hs[1] = hs[1] * dc + bfhi(s.x); hs[2] = hs[2] * dc + bflo(s.y); hs[3] = hs[3] * dc + bfhi(s.y);
                    hs[4] = hs[4] * dc + bflo(s.z); hs[5] = hs[5] * dc + bfhi(s.z); hs[6] = hs[6] * dc + bflo(s.w); hs[7] = hs[7] * dc + bfhi(s.w);
                }
            }
        } else if (ph == 5 && PH_EN(5)) {
            const bf16_t* XBCA = (const bf16_t*)((unsigned char*)ap->out); const bf16_t* PREV = (const bf16_t*)(ws + WS_STATES); const bf16_t* Z = (const bf16_t*)(ws + WS_Z);
            const float* ECSF = (const float*)(ws + WS_ECSF); const float* ECSB = (const float*)(ws + WS_ECSB); const bf16_t* YSSD = (const bf16_t*)(ws + WS_YSSD);
            bf16_t* YMIX = (bf16_t*)(ws + WS_YMIX); const bf16_t* P1 = (const bf16_t*)(ws + WS_ATTP1); const bf16_t* P2 = (const bf16_t*)(ws + WS_ATTP2); const bf16_t* P3 = (const bf16_t*)(ws + WS_ATTP3); const float* LSE = (const float*)(ws + WS_LSE);
            constexpr int GP = 2056, SSQ_OFF = 64 * GP;
            LAS float* SSQ = (LAS float*)(lds + SSQ_OFF);
            const int li = lane & 15, g4 = lane >> 4, tt = wave & 3, hh2 = wave >> 2;
            for (int L = vcu; L < 512; L += G) {
                const int b = L >> 5, c = (L >> 1) & 15, hf = L & 1;
                const size_t t0 = (size_t)b * SEQ + c * 128 + hf * 64;
                __syncthreads();
                float ssq = 0.f;
                const size_t tme = t0 + 16 * tt + li;
                for (int gi = 0; gi < 2; ++gi) {
                    const int grp = hh2 * 2 + gi;
                    bf16x8 cf[4];
#pragma unroll
                    for (int ks = 0; ks < 4; ++ks) cf[ks] = *(const bf16x8*)(XBCA + tme * 2048 + 1536 + grp * 128 + 32 * ks + 8 * g4);
                    for (int hx = 0; hx < 4; ++hx) {
                        const int h = grp * 4 + hx;
                        const size_t ei = ((size_t)(b * 16 + c) * 16 + h) * 128 + hf * 64 + 16 * tt + li; const float ef = ECSF[ei], eb = ECSB[ei];
#pragma unroll
                        for (int pt = 0; pt < 4; ++pt) {
                            f32x4 af = (f32x4){0.f, 0.f, 0.f, 0.f}, ab = (f32x4){0.f, 0.f, 0.f, 0.f};
                            const size_t hcx = (size_t)(b * 16 + c) * 16 + h;
                            const bf16_t* pf = PREV + hcx * 2 * 8192 + (pt * 4 * 64 + lane) * 8;
#pragma unroll
                            for (int ks = 0; ks < 4; ++ks) { af = MFMA16(*(const bf16x8*)(pf + ks * 512), cf[ks], af); ab = MFMA16(*(const bf16x8*)(pf + 8192 + ks * 512), cf[ks], ab); }
                            const int col = h * 64 + 16 * pt + 4 * g4;
                            const u32x2 yw = *(const u32x2*)(YSSD + hcx * 8192 + (((hf * 4 + tt) * 4 + pt) * 64 + lane) * 4); const f32x4 yd = (f32x4){bflo(yw.x), bfhi(yw.x), bflo(yw.y), bfhi(yw.y)};
                            const u32x2 zw = *(const u32x2*)(Z + tme * 1024 + col);
                            float gv[4];
                            gv[0] = (yd[0] + ef * af[0] + eb * ab[0]) * siluf(bflo(zw.x)); gv[1] = (yd[1] + ef * af[1] + eb * ab[1]) * siluf(bfhi(zw.x));
                            gv[2] = (yd[2] + ef * af[2] + eb * ab[2]) * siluf(bflo(zw.y)); gv[3] = (yd[3] + ef * af[3] + eb * ab[3]) * siluf(bfhi(zw.y));
                            ssq += (gv[0] * gv[0] + gv[1] * gv[1]) + (gv[2] * gv[2] + gv[3] * gv[3]);
                            u32x2 w; w.x = cvtpk(gv[0], gv[1]); w.y = cvtpk(gv[2], gv[3]);
                            *(LAS u32x2*)(lds + (16 * tt + li) * GP + col * 2) = w;
                        }
                    }
                }
                ssq += __shfl_xor(ssq, 16); ssq += __shfl_xor(ssq, 32);
                if (g4 == 0) SSQ[hh2 * 64 + 16 * tt + li] = ssq;
                __syncthreads();
#pragma unroll 4
                for (int k = 0; k < 16; ++k) {
                    const int id = tid + 512 * k, row = id >> 7, ch = id & 127;
                    const float rstd = 1.f / sqrtf((SSQ[row] + SSQ[64 + row]) * (1.f / 1024.f) + 1e-5f);
                    const u32x2 lo = *(const LAS u32x2*)(lds + row * GP + ch * 16), hi = *(const LAS u32x2*)(lds + row * GP + ch * 16 + 8);
                    const f32x4 w0 = *(const f32x4*)(ap->in[12] + ch * 8), w1 = *(const f32x4*)(ap->in[12] + ch * 8 + 4);
                    u32x4 o; o.x = cvtpk(bflo(lo.x) * rstd * w0[0], bfhi(lo.x) * rstd * w0[1]); o.y = cvtpk(bflo(lo.y) * rstd * w0[2], bfhi(lo.y) * rstd * w0[3]);
                    o.z = cvtpk(bflo(hi.x) * rstd * w1[0], bfhi(hi.x) * rstd * w1[1]); o.w = cvtpk(bflo(hi.y) * rstd * w1[2], bfhi(hi.y) * rstd * w1[3]);
                    *(u32x4*)(YMIX + (t0 + row) * 2048 + ch * 8) = o;
                }
#pragma unroll 4
                for (int k = 0; k < 8; ++k) {
                    const int id = tid + 512 * k, row = id >> 6, hd = (id >> 2) & 15, ec = id & 3; const size_t t = t0 + row;
                    const size_t li_ = ((size_t)(b * 16 + hd)) * SEQ + (t - (size_t)b * SEQ); const float l1 = LSE[li_], l2 = LSE[(size_t)T * 16 + li_], l3 = LSE[(size_t)2 * T * 16 + li_];
                    const float mx = fmaxf(l1, fmaxf(l2, l3)); float w1 = __expf(l1 - mx), w2 = __expf(l2 - mx), w3 = __expf(l3 - mx); const float iw = (1.f / 16.f) / (w1 + w2 + w3); w1 *= iw; w2 *= iw; w3 *= iw;
                    const size_t po = li_ * 64 + ec * 16;
                    const u32x4 o1 = *(const u32x4*)((const unsigned char*)P1 + po), o2 = *(const u32x4*)((const unsigned char*)P2 + po), o3 = *(const u32x4*)((const unsigned char*)P3 + po);
                    u32x4 oa, ob;
#pragma unroll
                    for (int q4 = 0; q4 < 4; ++q4) {
                        const f32x2 a0 = __builtin_amdgcn_cvt_pk_f32_fp8((int)o1[q4], false), a1 = __builtin_amdgcn_cvt_pk_f32_fp8((int)o1[q4], true);
                        const f32x2 b0 = __builtin_amdgcn_cvt_pk_f32_fp8((int)o2[q4], false), b1 = __builtin_amdgcn_cvt_pk_f32_fp8((int)o2[q4], true);
                        const f32x2 c0 = __builtin_amdgcn_cvt_pk_f32_fp8((int)o3[q4], false), c1 = __builtin_amdgcn_cvt_pk_f32_fp8((int)o3[q4], true);
                        const unsigned lo = cvtpk(w1 * a0.x + w2 * b0.x + w3 * c0.x, w1 * a0.y + w2 * b0.y + w3 * c0.y), hi = cvtpk(w1 * a1.x + w2 * b1.x + w3 * c1.x, w1 * a1.y + w2 * b1.y + w3 * c1.y);
                        if (q4 == 0) { oa.x = lo; oa.y = hi; } else if (q4 == 1) { oa.z = lo; oa.w = hi; } else if (q4 == 2) { ob.x = lo; ob.y = hi; } else { ob.z = lo; ob.w = hi; }
                    }
                    u32x4* yp = (u32x4*)(YMIX + t * 2048 + 1024 + hd * 64 + ec * 16);
                    yp[0] = oa; yp[1] = ob;
                }
            }
        } else if ((ph == 7 || ph == 11) && PH_EN(7)) {
            const float* gp = ph == 7 ? ap->in[14] : ap->in[20]; const float* bp = ph == 7 ? ap->in[15] : ap->in[21];
            for (int m = gw; m < T; m += NGW) {
                const u32x2* xr = (const u32x2*)((const bf16_t*)ap->out + (size_t)m * D) + lane; f32x4 v[4];
#pragma unroll
                for (int jx = 0; jx < 4; ++jx) { const u32x2 w = xr[64 * jx]; v[jx] = (f32x4){bflo(w.x), bfhi(w.x), bflo(w.y), bfhi(w.y)}; }
                if (ph == 11) ln_store_h8(v, gp, bp, HB + (size_t)m * D, ws + WS_HB8 + (size_t)m * D, lane);
                else ln_store<true>(v, gp, bp, HB + (size_t)m * D, lane);
            }
        } else if (ph == 9 && PH_EN(9)) {
            xattn_phase((const bf16_t*)(ws + WS_QM), (const bf16_t*)(ws + WS_KM), (bf16_t*)(ws + WS_XATT), lds, G, vcu, wave, lane);
        } else if (ph == 13 && PH_EN(13)) {
            const float* LOG = (const float*)(ws + WS_LOGITS); int* EIDX = (int*)(ws + WS_EIDX); int* POS = (int*)(ws + WS_POS); float* GATE = (float*)(ws + WS_GATE);
            int* BH = (int*)(ws + WS_BH) + ((PH == 20) ? 65536 : 0);
            LAS int* hist = (LAS int*)(lds + TAB_OFF);
            __syncthreads();
            if (tid < 256) hist[tid] = 0;
            __syncthreads();
            const f32x4 rb = *(const f32x4*)(ap->in[23] + 4 * lane);
            for (int t = gw; t < T; t += NGW) {
                const f32x4 lg = *(const f32x4*)(LOG + (size_t)t * 256 + 4 * lane);
                float s[4], c[4];
#pragma unroll
                for (int i = 0; i < 4; ++i) { s[i] = 1.f / (1.f + __expf(-lg[i])); c[i] = s[i] + rb[i]; }
                float ta = fmaxf(fmaxf(c[0], c[1]), fmaxf(c[2], c[3]));
                float tb;
                { const float m01 = fmaxf(c[0], c[1]), n01 = fminf(c[0], c[1]), m23 = fmaxf(c[2], c[3]), n23 = fminf(c[2], c[3]); tb = fmaxf(fminf(m01, m23), fmaxf(n01, n23)); }
#pragma unroll
                for (int o = 1; o < 8; o <<= 1) { const float oa = __shfl_xor(ta, o), ob = __shfl_xor(tb, o); const float na = fmaxf(ta, oa), nb = fmaxf(fminf(ta, oa), fmaxf(tb, ob)); ta = na; tb = nb; }
                const float gs = ta + tb; const int myg = lane >> 3;
                int rank = 0;
#pragma unroll
                for (int jx = 0; jx < 8; ++jx) { const float o = __builtin_bit_cast(float, __builtin_amdgcn_readlane(__builtin_bit_cast(int, gs), 8 * jx)); rank += (o > gs || (o == gs && jx < myg)) ? 1 : 0; }
                const bool sel = rank < 4;
                float h[4]; int hi_[4]; float hs[4];
#pragma unroll
                for (int i = 0; i < 4; ++i) { h[i] = sel ? c[i] : -1e30f; hi_[i] = 4 * lane + i; hs[i] = s[i]; }
#define CEX(x, y) do { const bool sw = (h[y] > h[x]); const float tv = sw ? h[y] : h[x], uv = sw ? h[x] : h[y]; const int ti = sw ? hi_[y] : hi_[x], ui = sw ? hi_[x] : hi_[y]; \
                       const float tsv = sw ? hs[y] : hs[x], usv = sw ? hs[x] : hs[y]; h[x] = tv; h[y] = uv; hi_[x] = ti; hi_[y] = ui; hs[x] = tsv; hs[y] = usv; } while (0)
                CEX(0, 1); CEX(2, 3); CEX(0, 2); CEX(1, 3); CEX(1, 2);
#undef CEX
                float wsum = 0.f; int myidx = 0; float myscore = 0.f;
#pragma unroll
                for (int k = 0; k < 8; ++k) {
                    const float mx = wave_max_dpp(h[0]);
                    const unsigned long long bal = __ballot(h[0] == mx);
                    const int own = (int)__builtin_ctzll(bal);
                    const int ei = __builtin_amdgcn_readlane(hi_[0], own);
                    const float sv = __builtin_bit_cast(float, __builtin_amdgcn_readlane(__builtin_bit_cast(int, hs[0]), own));
                    if (lane == own) { h[0] = h[1]; hi_[0] = hi_[1]; hs[0] = hs[1]; h[1] = h[2]; hi_[1] = hi_[2]; hs[1] = hs[2]; h[2] = h[3]; hi_[2] = hi_[3]; hs[2] = hs[3]; h[3] = -3e30f; }
                    wsum += sv;
                    if (lane == k) { myidx = ei; myscore = sv; }
                }
                if (lane < 8) {
                    EIDX[t * 8 + lane] = myidx; GATE[t * 8 + lane] = myscore / wsum * 2.5f;
                    POS[t * 8 + lane] = __hip_atomic_fetch_add(hist + myidx, 1, __ATOMIC_RELAXED, __HIP_MEMORY_SCOPE_WORKGROUP);
                }
            }
            __syncthreads();
            if (tid < 256) BH[vcu * 256 + tid] = hist[tid];
        } else if (ph == 14 && PH_EN(14)) {
            LAS int* tot = (LAS int*)(lds + TAB_OFF); LAS int* myb = tot + 256; LAS int* SBt = tot + 512;
            const int* BH = (const int*)(ws + WS_BH);
            __syncthreads();
            if (tid < 256) {
                int total = 0, mine = 0;
#pragma unroll 16
                for (int b2 = 0; b2 < G; ++b2) { const int v = ld_agent(BH + b2 * 256 + tid); total += v; mine += (b2 < vcu) ? v : 0; }
                tot[tid] = total; myb[tid] = mine;
                if (bx == 0) counts[tid] = total;
            }
            __syncthreads();
            if (wave == 0) {
                int c[4]; int ss = 0;
#pragma unroll
                for (int i = 0; i < 4; ++i) { c[i] = tot[4 * lane + i]; ss += c[i]; }
                int xs = ss;
#pragma unroll
                for (int o = 1; o < 64; o <<= 1) { const int ys = __shfl_up(xs, o); if (lane >= o) xs += ys; }
                int es = xs - ss;
#pragma unroll
                for (int i = 0; i < 4; ++i) { SBt[4 * lane + i] = es; es += c[i]; }
            }
            __syncthreads();
            const int* EIDX = (const int*)(ws + WS_EIDX); const int* POS = (const int*)(ws + WS_POS); int* SLOT = (int*)(ws + WS_SLOT); int* TOK = (int*)(ws + WS_TOK);
            for (int t = gw; t < T; t += NGW) if (lane < 8) { const int i = t * 8 + lane, e = EIDX[i]; const int sl = SBt[e] + myb[e] + POS[i]; SLOT[i] = sl; TOK[sl] = t; }
        } else if (ph == 18 && PH_EN(18)) {
            float* P18DST = (PH == 19) ? (float*)(ws + WS_WD) : ap->out;
            const unsigned char* YR = (const unsigned char*)(ws + WS_YROWS); const int* SLOT = (const int*)(ws + WS_SLOT); const float* GATE = (const float*)(ws + WS_GATE);
            for (int m0 = gw; m0 < T; m0 += 2 * NGW) {
                const int m1 = m0 + NGW;
                f32x4 va[4], vb[4]; u32x4 wa[8], wb[8]; float ga[8], gb[8];
                const u32x4* xa = (const u32x4*)((const bf16_t*)(ws + WS_PRE3) + (size_t)m0 * D) + 2 * lane; const u32x4* xb = (const u32x4*)((const bf16_t*)(ws + WS_PRE3) + (size_t)m1 * D) + 2 * lane;
#pragma unroll
                for (int k = 0; k < 8; ++k) {
                    const int sa = SLOT[m0 * 8 + k], sb = SLOT[m1 * 8 + k]; ga[k] = GATE[m0 * 8 + k] * (1.f / 32.f); gb[k] = GATE[m1 * 8 + k] * (1.f / 32.f);
                    wa[k] = *(const u32x4*)(YR + (size_t)sa * 1024 + 16 * lane); wb[k] = *(const u32x4*)(YR + (size_t)sb * 1024 + 16 * lane);
                }
#pragma unroll
                for (int jx = 0; jx < 2; ++jx) { const u32x4 pa = xa[jx], pb = xb[jx];
                    va[2 * jx] = (f32x4){bflo(pa.x), bfhi(pa.x), bflo(pa.y), bfhi(pa.y)}; va[2 * jx + 1] = (f32x4){bflo(pa.z), bfhi(pa.z), bflo(pa.w), bfhi(pa.w)};
                    vb[2 * jx] = (f32x4){bflo(pb.x), bfhi(pb.x), bflo(pb.y), bfhi(pb.y)}; vb[2 * jx + 1] = (f32x4){bflo(pb.z), bfhi(pb.z), bflo(pb.w), bfhi(pb.w)}; }
#pragma unroll
                for (int k = 0; k < 8; ++k)
#pragma unroll
                    for (int jx = 0; jx < 4; ++jx) {
                        { const int ww = (int)wa[k][jx]; const f32x2 lo = __builtin_amdgcn_cvt_pk_f32_fp8(ww, false), hi = __builtin_amdgcn_cvt_pk_f32_fp8(ww, true);
                          va[jx][0] += ga[k] * lo.x; va[jx][1] += ga[k] * lo.y; va[jx][2] += ga[k] * hi.x; va[jx][3] += ga[k] * hi.y; }
                        { const int ww = (int)wb[k][jx]; const f32x2 lo = __builtin_amdgcn_cvt_pk_f32_fp8(ww, false), hi = __builtin_amdgcn_cvt_pk_f32_fp8(ww, true);
                          vb[jx][0] += gb[k] * lo.x; vb[jx][1] += gb[k] * lo.y; vb[jx][2] += gb[k] * hi.x; vb[jx][3] += gb[k] * hi.y; }
                    }
                ln_store<false, true>(va, ap->in[30], ap->in[31], P18DST + (size_t)m0 * D, lane);
                ln_store<false, true>(vb, ap->in[30], ap->in[31], P18DST + (size_t)m1 * D, lane);
            }
        }
    }
}

__global__ void __launch_bounds__(512, 2) fwd(Args a_in) {
    extern __shared__ __attribute__((aligned(16))) unsigned char lds_raw[];
    LAS unsigned char* lds = (LAS unsigned char*)lds_raw;
    cg::grid_group grid = cg::this_grid();
    const int G = gridDim.x, bx = blockIdx.x;
    const int vcu = (G % 8 == 0) ? (bx % 8) * (G / 8) + bx / 8 : bx;
    const int ph_lo = a_in.ph_lo, ph_hi = a_in.ph_hi;
    volatile LAS unsigned* xst = (volatile LAS unsigned*)(lds + LDS_BYTES - 64);
    const int wv = __builtin_amdgcn_readfirstlane((int)threadIdx.x >> 6);
    { const int t0 = wv * 64 + lane_id(); if (t0 < 16) xst[t0] = 0u; }
    __syncthreads();
    const XcdBarrier xb = xcd_barrier_post((unsigned*)(a_in.ws + WS_CTL) + CW_BAR, xst, wv);
#ifndef REPMASK
#define REPMASK 0u
#endif
#define RUN(k) do { if (ph_lo <= (k) && (k) < ph_hi) { run_phase<k>(lds, a_in, G, bx, vcu, wv); if ((REPMASK >> (k)) & 1u) { xcd_barrier(xb, wv); run_phase<k>(lds, a_in, G, bx, vcu, wv); } } if (ph_lo <= (k) && (k) + 1 < ph_hi) { if ((k) == 0) grid.sync(); else xcd_barrier(xb, wv); } } while (0)
    RUN(0); RUN(1); RUN(2); RUN(3); RUN(4); RUN(5); RUN(6); RUN(7); RUN(8); RUN(9); RUN(10); RUN(11); RUN(12); RUN(13); RUN(14); RUN(15); RUN(17);
#ifdef PROBE18
    run_phase<19>(lds, a_in, G, bx, vcu, wv); xcd_barrier(xb, wv);
#endif
#ifdef PROBE17
    run_phase<21>(lds, a_in, G, bx, vcu, wv); xcd_barrier(xb, wv);
#endif
#ifdef PROBE13
    run_phase<20>(lds, a_in, G, bx, vcu, wv); xcd_barrier(xb, wv);
#endif
    RUN(18);
#undef RUN
}

extern "C" void kernel_launch(void* const* d_in, const int* in_sizes, int n_in, void* d_out, int out_size, void* d_ws, size_t ws_size, hipStream_t stream) {
    static int grid = 0;
    if (grid == 0) {
        if (n_in != 32 || out_size != T * D || ws_size < WS_END) { fprintf(stderr, "kernel_launch: unexpected shapes: n_in %d out %d ws %zu (need %zu)\n", n_in, out_size, ws_size, (size_t)WS_END); grid = -1; return; }
        int dev = 0, cus = 0, per_cu = 0;
        (void)hipGetDevice(&dev);
        (void)hipDeviceGetAttribute(&cus, hipDeviceAttributeMultiprocessorCount, dev);
        (void)hipFuncSetAttribute((const void*)fwd, hipFuncAttributeMaxDynamicSharedMemorySize, LDS_BYTES);
        (void)hipOccupancyMaxActiveBlocksPerMultiprocessor(&per_cu, (const void*)fwd, 512, LDS_BYTES);
        grid = cus;
        fprintf(stderr, "kernel_launch: grid %d (cus %d, occupancy query %d) ws %zu\n", grid, cus, per_cu, ws_size);
        if (per_cu < 1 || grid != 256) { fprintf(stderr, "kernel_launch: unsupported device geometry\n"); }
    }
    if (grid < 0) return;
    (void)hipMemsetAsync((char*)d_ws + WS_CTL, 0, CTL_BYTES, stream);
    Args a{};
    for (int i = 0; i < 32; ++i) a.in[i] = (const float*)d_in[i];
    a.out = (float*)d_out; a.ws = (unsigned char*)d_ws; a.ph_lo = 0; a.ph_hi = 19;
    void* args[] = {&a};
    hipError_t e = hipLaunchCooperativeKernel((const void*)fwd, dim3(grid), dim3(512), args, LDS_BYTES, stream);
    if (e != hipSuccess) fprintf(stderr, "kernel_launch: cooperative launch failed: %s\n", hipGetErrorString(e));
}
```

```cpp
#include <hip/hip_runtime.h>
#include <hip/hip_cooperative_groups.h>
#include <cstdio>
#include <cstdint>
namespace cg = cooperative_groups;

#define LAS __attribute__((address_space(3)))
typedef unsigned short bf16_t;
typedef short bf16x8 __attribute__((ext_vector_type(8)));
typedef short s16x4 __attribute__((ext_vector_type(4)));
typedef float f32x4 __attribute__((ext_vector_type(4)));
typedef float f32x2 __attribute__((ext_vector_type(2)));
typedef unsigned u32x4 __attribute__((ext_vector_type(4)));
typedef unsigned u32x2 __attribute__((ext_vector_type(2)));
typedef __bf16 bf16x2_t __attribute__((ext_vector_type(2)));

constexpr int T = 32768, D = 1024, SEQ = 2048, NBATCH = 16;
constexpr int NASSIGN = T * 8;
constexpr float DN_ALPHA = 1.189207115002721f;
constexpr float LOG2E = 1.4426950408889634f, LN2 = 0.6931471805599453f, QSCALE = 0.125f * LOG2E;
constexpr int LDS_BYTES = 155648;
constexpr int STG_OFF = 131072;
constexpr int TAB_OFF = 147456;
constexpr size_t MiB = 1u << 20;
constexpr size_t WS_CTL = 0, CTL_BYTES = 1 * MiB;
constexpr size_t WS_WIN = 1 * MiB, WS_WOUT = 14 * MiB, WS_WQ = 18 * MiB, WS_WK = 20 * MiB, WS_WV = 22 * MiB, WS_WO = 24 * MiB,
                 WS_WR = 26 * MiB, WS_WSGU = 27 * MiB, WS_WSD = 28 * MiB;
constexpr size_t WS_DTRAW = 29 * MiB, WS_DTF = 33 * MiB, WS_DTB = 35 * MiB, WS_ECSF = 37 * MiB, WS_ECSB = 39 * MiB, WS_DEC = 41 * MiB,
                 WS_LSE = 42 * MiB, WS_MEMB = 48 * MiB, WS_KM = 56 * MiB, WS_VT = 64 * MiB;
constexpr size_t WS_HB = 72 * MiB, WS_Z = 136 * MiB, WS_XBC = 200 * MiB, WS_STATES = 200 * MiB, WS_QKV = 328 * MiB, WS_YSSD = 328 * MiB,
                 WS_YMIX = 392 * MiB, WS_ATTP1 = 904 * MiB, WS_ATTP2 = 936 * MiB, WS_ATTP3 = 968 * MiB;
constexpr size_t WS_QM = 136 * MiB, WS_XATT = 200 * MiB;
constexpr size_t WS_HB80 = 904 * MiB, WS_WQKV8 = 42 * MiB;
constexpr size_t WS_HB8 = 200 * MiB;
constexpr float H8_SCALE = 16.f, W8_SCALE = 256.f, HID8_SCALE = 16.f;
__device__ __forceinline__ float clamp8(float x) { return __builtin_amdgcn_fmed3f(x, -448.f, 448.f); }
constexpr size_t WS_LOGITS = 136 * MiB, WS_HIDS = 168 * MiB, WS_EIDX = 184 * MiB, WS_POS = 185 * MiB, WS_SLOT = 186 * MiB, WS_GATE = 187 * MiB, WS_TOK = 188 * MiB, WS_BH = 190 * MiB;
constexpr size_t WS_WD = 520 * MiB, WS_WGU = 648 * MiB, WS_YROWS = 712 * MiB, WS_PRE3 = 392 * MiB, WS_HID = 264 * MiB, WS_END = 1024 * MiB;
constexpr int CW_COUNTS = 1024, CW_BAR = 4096;

__device__ __forceinline__ unsigned cvtpk(float lo, float hi) { f32x2 v = {lo, hi}; bf16x2_t b = __builtin_convertvector(v, bf16x2_t); return __builtin_bit_cast(unsigned, b); }
__device__ __forceinline__ float bflo(unsigned w) { return __builtin_bit_cast(float, w << 16); }
__device__ __forceinline__ float bfhi(unsigned w) { return __builtin_bit_cast(float, w & 0xffff0000u); }
__device__ __forceinline__ float bf1(bf16_t h) { return __builtin_bit_cast(float, (unsigned)h << 16); }
__device__ __forceinline__ float wave_sum(float v) {
#pragma unroll
    for (int o = 1; o < 64; o <<= 1) v += __shfl_xor(v, o);
    return v;
}
__device__ __forceinline__ float siluf(float x) { return x * __builtin_amdgcn_rcpf(1.f + __expf(-x)); }
__device__ __forceinline__ int ld_agent(const int* p) { return __hip_atomic_load(p, __ATOMIC_RELAXED, __HIP_MEMORY_SCOPE_AGENT); }
template <int CTRL, int ROWMASK> __device__ __forceinline__ float dppmax(float v) {
    const int o = __builtin_amdgcn_update_dpp(__builtin_bit_cast(int, v), __builtin_bit_cast(int, v), CTRL, ROWMASK, 0xf, false);
    return fmaxf(v, __builtin_bit_cast(float, o));
}
__device__ __forceinline__ float wave_max_dpp(float v) {
    v = dppmax<0x111, 0xf>(v); v = dppmax<0x112, 0xf>(v); v = dppmax<0x114, 0xf>(v); v = dppmax<0x118, 0xf>(v);
    v = dppmax<0x142, 0xa>(v); v = dppmax<0x143, 0xc>(v);
    return __builtin_bit_cast(float, __builtin_amdgcn_readlane(__builtin_bit_cast(int, v), 63));
}
#define LDS_WAIT() asm volatile("s_waitcnt lgkmcnt(0)" ::: "memory")
__device__ __forceinline__ int lane_id() { int l; asm volatile("v_mbcnt_lo_u32_b32 %0, -1, 0\n\tv_mbcnt_hi_u32_b32 %0, -1, %0" : "=v"(l)); return l; }
__device__ __forceinline__ s16x4 vtr(LAS const unsigned char* p) {
    typedef short v4i16_t __attribute__((ext_vector_type(4)));
    return __builtin_bit_cast(s16x4, __builtin_amdgcn_ds_read_tr16_b64_v4i16((LAS v4i16_t*)p));
}
__device__ __forceinline__ bf16x8 cat8(s16x4 lo, s16x4 hi) { return (bf16x8){lo[0], lo[1], lo[2], lo[3], hi[0], hi[1], hi[2], hi[3]}; }
#define MFMA16(a, b, c) __builtin_amdgcn_mfma_f32_16x16x32_bf16((a), (b), (c), 0, 0, 0)

#ifndef PHMASK
#define PHMASK 0xFFFFFFu
#endif
#define PH_EN(n) (((PHMASK) >> (n)) & 1u)
#ifndef GEMM_ONLY
#define GEMM_ONLY -1
#endif
#define JP(n) (GEMM_ONLY < 0 || GEMM_ONLY == (n))
struct Args { const float* in[32]; float* out; unsigned char* ws; int ph_lo, ph_hi; };

namespace pg8 {
constexpr int BM = 256, BK = 64, HALF = 128, HTB = HALF * BK * 2, STAGE_BYTES = 8 * HTB, NXCD = 8, WGM = 8;
__device__ __forceinline__ int lds_byte(int r, int c) { const int st = (r >> 4) * 2 + (c >> 5), rr = r & 15, cc = c & 31, ob = rr * 64 + cc * 2; return st * 1024 + (ob ^ (((ob >> 9) & 1) << 5)); }
__device__ __forceinline__ void stage_rc(int b, int& R, int& C) { const int st = b / 1024, sb = b % 1024, swz = sb ^ (((sb >> 9) & 1) << 5); R = (st >> 1) * 16 + swz / 64; C = (st & 1) * 32 + (swz % 64) / 2; }
__device__ __forceinline__ int perm32(int rho) { const int n = rho >> 4, i = rho & 15; return 8 * (i >> 2) + 4 * n + (i & 3); }

enum { M_PROJ = 0, M_BF16 = 1, M_RESBF16 = 2, M_F32 = 3, M_GATEUP = 4, M_FP8ROWS = 5, M_GATEUP8 = 6 };
struct GJob { const bf16_t* A; const bf16_t* Bt; int M, N, K, ldo; float alpha;
              void* o0; void* o1; void* o2; void* o3; const bf16_t* res; const int* tok; const bf16_t* xA; const bf16_t* xB; void* xO; };
struct GUnit { const char* a; const char* b; int orow, ocol, nvalid, pn, slot0; };

typedef int i32x8 __attribute__((ext_vector_type(8)));
typedef int i32x4_t __attribute__((ext_vector_type(4)));
typedef long i64x2_t __attribute__((ext_vector_type(2)));
__device__ __forceinline__ i32x8 cat32(bf16x8 lo, bf16x8 hi) { const i32x4_t a = __builtin_bit_cast(i32x4_t, lo), b = __builtin_bit_cast(i32x4_t, hi); return __builtin_shufflevector(a, b, 0, 1, 2, 3, 4, 5, 6, 7); }
template <int KIND> __device__ __forceinline__ bool gnext(const GJob& g, LAS const int* tabs, int G, int c, int vc, int i, GUnit& u) {
    if (KIND == 0) {
        const int nM = g.M / BM, nN = g.N / BM, nwg = nM * nN;
        const long L = (long)i * G + c;
        if (g.xA != nullptr && L >= nwg) {
            const int x = (int)L - nwg; if (x >= 128) return false;
            const int pm = x >> 3, pn = x & 7;
            u.a = (const char*)g.xA + (size_t)pm * BM * g.K * 2; u.b = (const char*)g.xB + (size_t)pn * BM * g.K * 2;
            u.orow = pm * BM; u.ocol = pn * BM; u.nvalid = BM; u.pn = 100 + pn; u.slot0 = 0; return true;
        }
        if (L >= nwg) return false;
        int wgid = (int)L; { const int q = nwg / NXCD, r = nwg % NXCD, xcd = wgid % NXCD, off = wgid / NXCD; wgid = (xcd < r ? xcd * (q + 1) : r * (q + 1) + (xcd - r) * q) + off; }
        const int nig = WGM * nN, gid = wgid / nig, fm = gid * WGM, gsz = (nM - fm) < WGM ? (nM - fm) : WGM;
        const int pm = fm + ((wgid % nig) % gsz), pn = (wgid % nig) / gsz;
        u.a = (const char*)g.A + (size_t)pm * BM * g.K * 2; u.b = (const char*)g.Bt + (size_t)pn * BM * g.K * 2;
        u.orow = pm * BM; u.ocol = pn * BM; u.nvalid = BM; u.pn = pn; u.slot0 = 0;
        if (g.N == 3328 && pn == 12) { u.b = (const char*)g.Bt + (size_t)24 * BM * g.K * 2; u.pn = 24; }
        if (g.N == 3072) u.pn = pn + 12;
        return true;
    }
    LAS const int* CN = tabs; LAS const int* TP = tabs + 256; LAS const int* SB = tabs + 256 + 260;
    const int ncol = KIND == 1 ? 2 : 4;
#define RFL(x) __builtin_amdgcn_readfirstlane(x)
    const int L = i * G + vc; if (L >= RFL(TP[256]) * ncol) return false;
    const int tile = L / ncol, pn = L % ncol;
    int lo = 0, hi = 256;
    while (hi - lo > 1) { const int mid = (lo + hi) >> 1; if (RFL(TP[mid]) <= tile) lo = mid; else hi = mid; }
    const int e = lo, tin = tile - RFL(TP[e]), slot0 = RFL(SB[e]) + tin * 256; int nv = RFL(CN[e]) - tin * 256; nv = nv > 256 ? 256 : nv;
#undef RFL
    u.orow = slot0; u.slot0 = slot0; u.nvalid = nv; u.pn = pn;
    if (KIND == 1) { u.a = (const char*)g.A; u.b = (const char*)g.Bt + ((size_t)e * 512 + pn * 256) * g.K * 2; u.ocol = pn * 128; }
    else { u.a = (const char*)g.A + (size_t)slot0 * g.K * 2; u.b = (const char*)g.Bt + ((size_t)e * 1024 + pn * 256) * g.K * 2; u.ocol = pn * 256; }
    return true;
}
template <int KIND> __device__ __forceinline__ void unit_voff(const GJob& g, const GUnit& u, int tid, unsigned (&v)[2][2]) {
#pragma unroll
    for (int i = 0; i < 2; ++i) {
        int R, C; stage_rc(tid * 16 + i * 8192, R, C);
#pragma unroll
        for (int h = 0; h < 2; ++h) {
            if (KIND == 1) { int s = u.slot0 + h * HALF + R; s = s < NASSIGN ? s : NASSIGN - 1; const int tk = g.tok[s]; v[h][i] = (unsigned)(tk * g.K + C) * 2u; }
            else v[h][i] = (unsigned)(R * g.K + C) * 2u;
        }
    }
}

__device__ __forceinline__ void stg_write(LAS unsigned char* wst, int fr, int slot, u32x4 v) { *(LAS u32x4*)(wst + fr * 128 + ((slot ^ (fr & 7)) << 4)) = v; }
__device__ __forceinline__ u32x4 stg_read(LAS const unsigned char* wst, int r, int c) { return *(const LAS u32x4*)(wst + r * 128 + ((c ^ (r & 7)) << 4)); }
template <int MODE, int F8 = 0> __device__ __forceinline__ void gemm_epi(const GJob& g, const GUnit& u, const f32x4 (&acc)[2][2][4][2], LAS unsigned char* wst, int wr, int wc, int fr, int fq) {
    const int lane = fq * 16 + fr, rr0 = lane >> 3, cc = lane & 7;
    if (MODE == M_PROJ || MODE == M_BF16 || MODE == M_RESBF16) {
        bf16_t* base = (bf16_t*)g.o0; int ld = g.ldo, c0 = u.ocol;
        if (MODE == M_PROJ) {
            const int pn = u.pn;
            if (pn == 24) {
                if (wc == 0) { float* dt = (float*)g.o3;
#pragma unroll
                    for (int ai = 0; ai < 2; ++ai)
#pragma unroll
                        for (int m = 0; m < 4; ++m) { float* p = dt + (size_t)(u.orow + ai * HALF + wr * 64 + m * 16 + fr) * 32 + 8 * fq; *(f32x4*)p = acc[ai][0][m][0]; *(f32x4*)(p + 4) = acc[ai][0][m][1]; } }
                return;
            }
            if (pn < 4) { base = (bf16_t*)g.o0; ld = 1024; c0 = pn * 256; } else if (pn < 12) { base = (bf16_t*)g.o1; ld = 2048; c0 = (pn - 4) * 256; } else if (pn < 24) {
                base = (bf16_t*)g.o2 + ((size_t)((((pn - 12) >> 2) * 16 + (u.orow >> 11)) * 16 + 4 * ((pn - 12) & 3) + wc) * SEQ + (u.orow & (SEQ - 1))) * 64 - (size_t)u.orow * 64; ld = 64; c0 = -wc * 64; }
            else { base = (bf16_t*)g.xO; ld = 2048; c0 = (pn - 100) * 256; }
        }
        const float osc = ((MODE == M_PROJ && u.pn >= 12 && u.pn < 16) ? QSCALE : 1.f) * (F8 ? 1.f / (H8_SCALE * W8_SCALE) : 1.f);
#pragma unroll
        for (int ai = 0; ai < 2; ++ai)
#pragma unroll
            for (int m = 0; m < 4; ++m) {
#pragma unroll
                for (int bj = 0; bj < 2; ++bj) { const f32x4 v0 = acc[ai][bj][m][0] * osc, v1 = acc[ai][bj][m][1] * osc;
                    u32x4 w; w.x = cvtpk(v0[0], v0[1]); w.y = cvtpk(v0[2], v0[3]); w.z = cvtpk(v1[0], v1[1]); w.w = cvtpk(v1[2], v1[3]); stg_write(wst, fr, 4 * bj + fq, w); }
                asm volatile("" ::: "memory");
#pragma unroll
                for (int i = 0; i < 2; ++i) { const int r = 8 * i + rr0, rl = ai * HALF + wr * 64 + m * 16 + r;
                    u32x4 w = stg_read(wst, r, cc);
                    if (rl < u.nvalid) { const size_t o = (size_t)(u.orow + rl) * ld + c0 + wc * 64 + 8 * cc;
                        if (MODE == M_RESBF16) { const u32x4 rs = *(const u32x4*)(g.res + o);
                            w.x = cvtpk(bflo(w.x) + g.alpha * bflo(rs.x), bfhi(w.x) + g.alpha * bfhi(rs.x)); w.y = cvtpk(bflo(w.y) + g.alpha * bflo(rs.y), bfhi(w.y) + g.alpha * bfhi(rs.y));
                            w.z = cvtpk(bflo(w.z) + g.alpha * bflo(rs.z), bfhi(w.z) + g.alpha * bfhi(rs.z)); w.w = cvtpk(bflo(w.w) + g.alpha * bflo(rs.w), bfhi(w.w) + g.alpha * bfhi(rs.w)); }
                        *(u32x4*)(base + o) = w; } }
                asm volatile("" ::: "memory");
            }
    } else if (MODE == M_F32) {
        float* out = (float*)g.o0;
#pragma unroll
        for (int ai = 0; ai < 2; ++ai)
#pragma unroll
            for (int m = 0; m < 4; ++m)
#pragma unroll
                for (int bj = 0; bj < 2; ++bj) {
#pragma unroll
                    for (int n = 0; n < 2; ++n) stg_write(wst, fr, 4 * n + fq, __builtin_bit_cast(u32x4, acc[ai][bj][m][n]));
                    asm volatile("" ::: "memory");
#pragma unroll
                    for (int i = 0; i < 2; ++i) { const int r = 8 * i + rr0, rl = ai * HALF + wr * 64 + m * 16 + r;
                        const u32x4 w = stg_read(wst, r, cc);
                        if (rl < u.nvalid) *(u32x4*)(out + (size_t)(u.orow + rl) * g.ldo + u.ocol + wc * 64 + bj * 32 + 4 * cc) = w; }
                    asm volatile("" ::: "memory");
                }
    } else if (MODE == M_FP8ROWS) {
        unsigned char* out = (unsigned char*)g.o0;
#pragma unroll
        for (int ai = 0; ai < 2; ++ai)
#pragma unroll
            for (int m = 0; m < 4; ++m) {
#pragma unroll
                for (int bj = 0; bj < 2; ++bj) { const f32x4 v0 = acc[ai][bj][m][0] * (32.f / (HID8_SCALE * W8_SCALE)), v1 = acc[ai][bj][m][1] * (32.f / (HID8_SCALE * W8_SCALE));
                    int w0 = 0, w1 = 0;
                    w0 = __builtin_amdgcn_cvt_pk_fp8_f32(v0[0], v0[1], w0, false); w0 = __builtin_amdgcn_cvt_pk_fp8_f32(v0[2], v0[3], w0, true);
                    w1 = __builtin_amdgcn_cvt_pk_fp8_f32(v1[0], v1[1], w1, false); w1 = __builtin_amdgcn_cvt_pk_fp8_f32(v1[2], v1[3], w1, true);
                    u32x2 w; w.x = (unsigned)w0; w.y = (unsigned)w1;
                    *(LAS u32x2*)(wst + fr * 64 + (((2 * bj + (fq >> 1)) ^ (fr & 3)) << 4) + (fq & 1) * 8) = w; }
                asm volatile("" ::: "memory");
                { const int r = lane >> 2, c4 = lane & 3, rl = ai * HALF + wr * 64 + m * 16 + r;
                  const u32x4 w = *(const LAS u32x4*)(wst + r * 64 + ((c4 ^ (r & 3)) << 4));
                  if (rl < u.nvalid) *(u32x4*)(out + (size_t)(u.orow + rl) * 1024 + u.ocol + wc * 64 + 16 * c4) = w; }
                asm volatile("" ::: "memory");
            }
    } else if (MODE == M_GATEUP8) {
        unsigned char* out = (unsigned char*)g.o0; const float isc = 1.f / (H8_SCALE * W8_SCALE);
#pragma unroll
        for (int ai = 0; ai < 2; ++ai)
#pragma unroll
            for (int m = 0; m < 4; ++m) { const int rl = ai * HALF + wr * 64 + m * 16 + fr;
                if (rl < u.nvalid) { unsigned char* rowp = out + (size_t)(u.orow + rl) * 256 + u.pn * 128 + wc * 32 + 8 * fq;
                    float hv[8];
#pragma unroll
                    for (int n = 0; n < 2; ++n)
#pragma unroll
                        for (int j = 0; j < 4; ++j) hv[n * 4 + j] = clamp8(siluf(acc[ai][0][m][n][j] * isc) * (acc[ai][1][m][n][j] * (isc * HID8_SCALE)));
                    int w0 = 0, w1 = 0;
                    w0 = __builtin_amdgcn_cvt_pk_fp8_f32(hv[0], hv[1], w0, false); w0 = __builtin_amdgcn_cvt_pk_fp8_f32(hv[2], hv[3], w0, true);
                    w1 = __builtin_amdgcn_cvt_pk_fp8_f32(hv[4], hv[5], w1, false); w1 = __builtin_amdgcn_cvt_pk_fp8_f32(hv[6], hv[7], w1, true);
                    u32x2 w; w.x = (unsigned)w0; w.y = (unsigned)w1; *(u32x2*)rowp = w; } }
    } else {
        bf16_t* out = (bf16_t*)g.o0;
#pragma unroll
        for (int ai = 0; ai < 2; ++ai)
#pragma unroll
            for (int m = 0; m < 4; ++m) { const int rl = ai * HALF + wr * 64 + m * 16 + fr;
                if (rl < u.nvalid) { bf16_t* rowp = out + (size_t)(u.orow + rl) * 256 + u.pn * 128 + wc * 32 + 8 * fq;
                    float hv[8];
#pragma unroll
                    for (int n = 0; n < 2; ++n)
#pragma unroll
                        for (int j = 0; j < 4; ++j) hv[n * 4 + j] = siluf(acc[ai][0][m][n][j]) * acc[ai][1][m][n][j];
                    u32x4 w; w.x = cvtpk(hv[0], hv[1]); w.y = cvtpk(hv[2], hv[3]); w.z = cvtpk(hv[4], hv[5]); w.w = cvtpk(hv[6], hv[7]); *(u32x4*)rowp = w; } }
    }
}

template <int KIND, int MODE, int PERM, int F8 = 0> __device__ __forceinline__ void gemm_phase(LAS unsigned char* lds, const GJob& g, int G, int cidx, int vcu, int wvx, int u_lo = 0, int u_hi = 1 << 30) {
    int tid = wvx * 64 + lane_id(); asm volatile("" : "+v"(tid));
    const int wid = __builtin_amdgcn_readfirstlane(tid >> 6), lane = tid & 63, wr = wid >> 2, wc = wid & 3, fr = lane & 15, fq = lane >> 4;
    const int K = g.K, nt = K / BK;
    LAS const int* tabs = (LAS const int*)(lds + TAB_OFF);
    unsigned voffB[2];
#pragma unroll
    for (int i = 0; i < 2; ++i) { int R, C; stage_rc(tid * 16 + i * 8192, R, C); const int rho = PERM ? perm32(R & 31) : (R & 31); voffB[i] = (unsigned)((64 * (R >> 5) + rho) * K + C) * 2u; }
    const size_t hstepB = (size_t)32 * K * 2, hstepA = (KIND == 1) ? 0 : (size_t)HALF * K * 2;
    LAS unsigned char* wst = lds + STG_OFF + wid * 2048;
#define VA1 vA[KIND == 1 ? 1 : 0]
    const size_t kstep = (size_t)(BK * 2);
    const unsigned ldsw = (unsigned)wid * 1024u;
    const int aoff = lds_byte(wr * 64 + fr, fq * 8), boff = lds_byte(wc * 32 + fr, fq * 8);
#define PG8_SA(b, h) (((b) * 2 + (h)) * HTB)
#define PG8_SB(b, h) ((4 + (b) * 2 + (h)) * HTB)
#define PG8_STG(bufoff, gbase, voff) do { _Pragma("unroll") for (int _i = 0; _i < 2; ++_i) \
        __builtin_amdgcn_global_load_lds((const unsigned*)((const char*)(gbase) + (voff)[_i]), (LAS unsigned*)(lds + (bufoff) + ldsw + _i * 8192), 16, 0, 0); } while (0)
#define PG8_LDA(dst, b, h) do { _Pragma("unroll") for (int m = 0; m < 4; ++m) _Pragma("unroll") for (int k = 0; k < 2; ++k) dst[m][k] = *(const LAS bf16x8*)(lds + PG8_SA(b, h) + aoff + m * 2048 + k * 1024); } while (0)
#define PG8_LDB(dst, b, h) do { _Pragma("unroll") for (int n = 0; n < 2; ++n) _Pragma("unroll") for (int k = 0; k < 2; ++k) dst[n][k] = *(const LAS bf16x8*)(lds + PG8_SB(b, h) + boff + n * 2048 + k * 1024); } while (0)
#define PG8_MMA(ai, bj, At, Bt) do { __builtin_amdgcn_s_setprio(1); _Pragma("unroll") for (int m = 0; m < 4; ++m) _Pragma("unroll") for (int n = 0; n < 2; ++n) { \
        if (F8 == 2) { const i32x8 b8_ = cat32(Bt[n][0], Bt[n][1]), a8_ = cat32(At[m][0], At[m][1]); asm volatile("v_mfma_scale_f32_16x16x128_f8f6f4 %0, %1, %2, %0, %3, %3 op_sel_hi:[0,0,0]" : "+v"(acc[ai][bj][m][n]) : "v"(b8_), "v"(a8_), "v"(sc1_)); } \
        else if (F8) acc[ai][bj][m][n] = __builtin_amdgcn_mfma_scale_f32_16x16x128_f8f6f4(cat32(Bt[n][0], Bt[n][1]), cat32(At[m][0], At[m][1]), acc[ai][bj][m][n], 0, 0, 0, 0x7F7F7F7F, 0, 0x7F7F7F7F); \
        else { _Pragma("unroll") for (int k = 0; k < 2; ++k) acc[ai][bj][m][n] = __builtin_amdgcn_mfma_f32_16x16x32_bf16(Bt[n][k], At[m][k], acc[ai][bj][m][n], 0, 0, 0); } } __builtin_amdgcn_s_setprio(0); } while (0)
#define PG8_WAIT_V(n) asm volatile("s_waitcnt vmcnt(" #n ")" ::: "memory")
#define PG8_WAIT_L(n) asm volatile("s_waitcnt lgkmcnt(" #n ")" ::: "memory")
#define PG8_BAR __builtin_amdgcn_s_barrier()
#define PG8_SCHED __builtin_amdgcn_sched_barrier(0)
    int sc1_ = 0x7F7F7F7F; if (F8 == 2) asm volatile("" : "+v"(sc1_));
    GUnit cur, nxt; int ui = u_lo;
    while (ui < u_hi && gnext<KIND>(g, tabs, G, cidx, vcu, ui, cur)) {
        unsigned vA[2][2];
        unit_voff<KIND>(g, cur, tid, vA);
        f32x4 acc[2][2][4][2];
#pragma unroll
        for (int a = 0; a < 2; ++a)
#pragma unroll
            for (int b = 0; b < 2; ++b)
#pragma unroll
                for (int m = 0; m < 4; ++m)
#pragma unroll
                    for (int n = 0; n < 2; ++n) acc[a][b][m][n] = (f32x4){0.f, 0.f, 0.f, 0.f};
        bf16x8 At[4][2], B0[2][2], B1[2][2];
        const char* cA = cur.a; const char* cB = cur.b;
        PG8_STG(PG8_SB(0, 0), cB, voffB); PG8_STG(PG8_SB(0, 1), cB + hstepB, voffB); PG8_STG(PG8_SA(0, 0), cA, vA[0]); PG8_STG(PG8_SA(0, 1), cA + hstepA, VA1);
        if (wr == 1) PG8_BAR;
        PG8_WAIT_V(2); PG8_BAR;
        PG8_STG(PG8_SB(1, 0), cB + kstep, voffB); PG8_STG(PG8_SA(1, 0), cA + kstep, vA[0]); PG8_STG(PG8_SB(1, 1), cB + hstepB + kstep, voffB);
        PG8_WAIT_V(6); PG8_BAR;
        for (;;) {
            const bool has_next = (ui + 1 < u_hi) && gnext<KIND>(g, tabs, G, cidx, vcu, ui + 1, nxt);
            if (KIND == 1 && has_next) {
                unsigned nv[2][2]; unit_voff<KIND>(g, nxt, tid, nv);
                *(LAS u32x4*)(lds + STG_OFF + tid * 16) = (u32x4){nv[0][0], nv[0][1], nv[1][0], nv[1][1]};
            }
            const char* nA = has_next ? nxt.a : cA; const char* nB = has_next ? nxt.b : cB;
            for (int t = 0; t < nt; t += 2) {
                const bool last = (t == nt - 2);
                const char* a1 = cA + (size_t)(t + 1) * kstep;
                const char* a2 = last ? nA : cA + (size_t)(t + 2) * kstep; const char* b2 = last ? nB : cB + (size_t)(t + 2) * kstep;
                const char* a3 = a2 + kstep; const char* b3 = b2 + kstep;
                PG8_LDB(B0, 0, 0); PG8_LDB(B1, 0, 1); PG8_SCHED; PG8_LDA(At, 0, 0); PG8_STG(PG8_SA(1, 1), a1 + hstepA, VA1);
                if (KIND == 1 && last && has_next) {
                    const u32x4 nv = *(const LAS u32x4*)(lds + STG_OFF + tid * 16); vA[0][0] = nv.x; vA[0][1] = nv.y; vA[1][0] = nv.z; vA[1][1] = nv.w; }
                PG8_WAIT_V(8); PG8_WAIT_L(0); PG8_BAR; PG8_MMA(0, 0, At, B0); PG8_MMA(0, 1, At, B1); PG8_BAR; PG8_SCHED;
                PG8_LDA(At, 0, 1); PG8_STG(PG8_SB(0, 0), b2, voffB); PG8_STG(PG8_SB(0, 1), b2 + hstepB, voffB); PG8_STG(PG8_SA(0, 0), a2, vA[0]);
                PG8_WAIT_V(8); PG8_WAIT_L(0); PG8_BAR; PG8_MMA(1, 0, At, B0); PG8_MMA(1, 1, At, B1); PG8_BAR; PG8_SCHED;
                PG8_LDB(B0, 1, 0); PG8_LDB(B1, 1, 1); PG8_SCHED; PG8_LDA(At, 1, 0); PG8_STG(PG8_SA(0, 1), a2 + hstepA, VA1);
                PG8_WAIT_V(8); PG8_WAIT_L(0); PG8_BAR; PG8_MMA(0, 0, At, B0); PG8_MMA(0, 1, At, B1); PG8_BAR; PG8_SCHED;
                PG8_LDA(At, 1, 1); PG8_STG(PG8_SB(1, 0), b3, voffB); PG8_STG(PG8_SB(1, 1), b3 + hstepB, voffB); PG8_STG(PG8_SA(1, 0), a3, vA[0]);
                PG8_WAIT_V(8); PG8_WAIT_L(0); PG8_BAR; PG8_MMA(1, 0, At, B0); PG8_MMA(1, 1, At, B1); PG8_BAR; PG8_SCHED;
            }
            if (wr == 0) PG8_BAR;
            if (F8 == 2) asm volatile("s_nop 15\n\ts_nop 15\n\ts_nop 15" ::: "memory");
            gemm_epi<MODE, F8>(g, cur, acc, wst, wr, wc, fr, fq);
            ++ui;
            if (!has_next) break;
#pragma unroll
            for (int a = 0; a < 2; ++a)
#pragma unroll
                for (int b = 0; b < 2; ++b)
#pragma unroll
                    for (int m = 0; m < 4; ++m)
#pragma unroll
                        for (int n = 0; n < 2; ++n) acc[a][b][m][n] = (f32x4){0.f, 0.f, 0.f, 0.f};
            cur = nxt; cA = nA; cB = nB;
            if (wr == 1) PG8_BAR;
        }
        PG8_WAIT_V(0);
        PG8_BAR;
    }
#undef VA1
#undef PG8_SA
#undef PG8_SB
#undef PG8_STG
#undef PG8_LDA
#undef PG8_LDB
#undef PG8_MMA
#undef PG8_WAIT_V
#undef PG8_WAIT_L
#undef PG8_BAR
#undef PG8_SCHED
}
}

struct TrJob { const float* W; bf16_t* WT; int ldw, ncols, K, ldt, map, p0; };
__device__ __forceinline__ int tr_row(const TrJob& j, int n) {
    if (j.map == 0) return n + j.p0;
    if (j.map == 1) return n < 3072 ? n : (n < 3104 ? 6144 + (n - 3072) : n - 32);
    return 256 * (n >> 7) + 64 * ((n & 127) >> 5) + (n & 31) + j.p0;
}
template <bool CHK> __device__ __forceinline__ void tr_load(const TrJob& j, int item, f32x4 (&v)[16], int lane) {
    const int nnb = (j.ncols + 63) >> 6, kb = item / nnb, nb = item % nnb, k0 = kb * 64, n0 = nb * 64;
    const int q = lane & 15, r = lane >> 4, n = n0 + 4 * q;
    const float* p = j.W + (size_t)(k0 + r) * j.ldw + n; const size_t step = (size_t)4 * j.ldw;
#pragma unroll
    for (int it = 0; it < 16; ++it) {
        v[it] = (f32x4){0.f, 0.f, 0.f, 0.f};
        if (!CHK || n < j.ncols) v[it] = *(const f32x4*)p;
        p += step;
    }
}
template <bool CHK> __device__ __forceinline__ void tr_finish(const TrJob& j, int item, const f32x4 (&v)[16], LAS float* scr, int lane) {
    const int nnb = (j.ncols + 63) >> 6, kb = item / nnb, nb = item % nnb, k0 = kb * 64, n0 = nb * 64;
    const int q = lane & 15, r = lane >> 4;
#pragma unroll
    for (int it = 0; it < 16; ++it) { const int kk = it * 4 + r; LAS float* s = scr + kk * 65 + 4 * q; s[0] = v[it][0]; s[1] = v[it][1]; s[2] = v[it][2]; s[3] = v[it][3]; }
    LDS_WAIT();
    const int c = lane & 7;
#pragma unroll
    for (int it = 0; it < 8; ++it) {
        const int nn = it * 8 + (lane >> 3), n = n0 + nn;
        if (!CHK || n < j.ncols) {
            const LAS float* s = scr + (8 * c) * 65 + nn;
            u32x4 o; o.x = cvtpk(s[0], s[65]); o.y = cvtpk(s[2 * 65], s[3 * 65]); o.z = cvtpk(s[4 * 65], s[5 * 65]); o.w = cvtpk(s[6 * 65], s[7 * 65]);
            *(u32x4*)(j.WT + (size_t)tr_row(j, n) * j.ldt + k0 + 8 * c) = o;
        }
    }
    LDS_WAIT();
}
template <bool CHK> __device__ __forceinline__ void tr_finish8(const TrJob& j, int item, const f32x4 (&v)[16], LAS float* scr, int lane) {
    const int nnb = (j.ncols + 63) >> 6, kb = item / nnb, nb = item % nnb, k0 = kb * 64, n0 = nb * 64;
    const int q = lane & 15, r = lane >> 4;
#pragma unroll
    for (int it = 0; it < 16; ++it) { const int kk = it * 4 + r; LAS float* s = scr + kk * 65 + 4 * q; s[0] = v[it][0]; s[1] = v[it][1]; s[2] = v[it][2]; s[3] = v[it][3]; }
    LDS_WAIT();
    const int c4 = lane & 3;
#pragma unroll
    for (int it = 0; it < 4; ++it) {
        const int nn = it * 16 + (lane >> 2), n = n0 + nn;
        if (!CHK || n < j.ncols) {
            const LAS float* s = scr + (16 * c4) * 65 + nn;
            u32x4 o;
#pragma unroll
            for (int qq = 0; qq < 4; ++qq) { int w = 0;
                w = __builtin_amdgcn_cvt_pk_fp8_f32(clamp8(s[(4 * qq) * 65] * W8_SCALE), clamp8(s[(4 * qq + 1) * 65] * W8_SCALE), w, false);
                w = __builtin_amdgcn_cvt_pk_fp8_f32(clamp8(s[(4 * qq + 2) * 65] * W8_SCALE), clamp8(s[(4 * qq + 3) * 65] * W8_SCALE), w, true); o[qq] = (unsigned)w; }
            *(u32x4*)((unsigned char*)j.WT + (size_t)tr_row(j, n) * j.ldt + k0 + 16 * c4) = o;
        }
    }
    LDS_WAIT();
}
template <bool CHK = false, bool F8 = false> __device__ __forceinline__ void tr_run(const TrJob& j, int nrep, size_t wstride, size_t tstride, LAS float* scr, int gw, int NGW, int lane, int& off) {
    const int per = (j.K / 64) * ((j.ncols + 63) >> 6); const long total = (long)per * nrep;
    long start = ((long)gw - off) % NGW; if (start < 0) start += NGW;
    off = (int)((off + total) % NGW);
#define TR_JOB(jj, it) TrJob jj = j; { const int e_ = (int)((it) / per); jj.W += (size_t)e_ * wstride; jj.WT += (size_t)e_ * tstride; }
    long it = start;
    for (; it + (long)NGW < total; it += 2 * (long)NGW) {
        f32x4 va[16], vb[16];
        const long i1 = it + NGW;
        { TR_JOB(j0, it); tr_load<CHK>(j0, (int)(it % per), va, lane); }
        __builtin_amdgcn_sched_barrier(0);
        { TR_JOB(j1, i1); tr_load<CHK>(j1, (int)(i1 % per), vb, lane); }
        __builtin_amdgcn_sched_barrier(0);
        { TR_JOB(j0, it); if (F8) tr_finish8<CHK>(j0, (int)(it % per), va, scr, lane); else tr_finish<CHK>(j0, (int)(it % per), va, scr, lane); }
        __builtin_amdgcn_sched_barrier(0);
        { TR_JOB(j1, i1); if (F8) tr_finish8<CHK>(j1, (int)(i1 % per), vb, scr, lane); else tr_finish<CHK>(j1, (int)(i1 % per), vb, scr, lane); }
    }
    for (; it < total; it += NGW) { f32x4 va[16]; TR_JOB(j0, it); tr_load<CHK>(j0, (int)(it % per), va, lane); if (F8) tr_finish8<CHK>(j0, (int)(it % per), va, scr, lane); else tr_finish<CHK>(j0, (int)(it % per), va, scr, lane); }
#undef TR_JOB
}

__device__ __forceinline__ void convert_expert_weights(const float* wg, const float* wu, const float* wd, unsigned char* ws, LAS unsigned char* lds, int vcu, int NGW, int wvx) {
    int tid = wvx * 64 + lane_id(); asm volatile("" : "+v"(tid));
    const int lane = tid & 63, wave = __builtin_amdgcn_readfirstlane(tid >> 6), gw = vcu * 8 + wave;
    LAS float* scr = (LAS float*)(lds + wave * (64 * 65 * 4)); int off = 0;
    TrJob j; j.ldw = 256; j.ncols = 256; j.K = 1024; j.ldt = 1024; j.map = 2; j.WT = (bf16_t*)(ws + WS_WGU);
    j.W = wg; j.p0 = 0; tr_run<false, true>(j, 256, (size_t)1024 * 256, (size_t)512 * 1024 / 2, scr, gw, NGW, lane, off);
    j.W = wu; j.p0 = 32; tr_run<false, true>(j, 256, (size_t)1024 * 256, (size_t)512 * 1024 / 2, scr, gw, NGW, lane, off);
    j.ldw = 1024; j.ncols = 1024; j.K = 256; j.ldt = 256; j.map = 0; j.p0 = 0; j.WT = (bf16_t*)(ws + WS_WD); j.W = wd;
    tr_run<false, true>(j, 256, (size_t)256 * 1024, (size_t)1024 * 256 / 2, scr, gw, NGW, lane, off);
}

template <bool OUT_BF16, bool CONSEC = false>
__device__ __forceinline__ void ln_store(f32x4 (&v)[4], const float* g, const float* b, void* orow, int lane) {
    float s = 0.f;
#pragma unroll
    for (int j = 0; j < 4; ++j) s += (v[j].x + v[j].y) + (v[j].z + v[j].w);
    const float mean = wave_sum(s) * (1.f / D); float s2 = 0.f;
#pragma unroll
    for (int j = 0; j < 4; ++j) { v[j] = v[j] - mean; s2 += (v[j].x * v[j].x + v[j].y * v[j].y) + (v[j].z * v[j].z + v[j].w * v[j].w); }
    const float rstd = 1.f / sqrtf(wave_sum(s2) * (1.f / D) + 1e-5f);
#pragma unroll
    for (int j = 0; j < 4; ++j) {
        const int ci = CONSEC ? 4 * lane + j : lane + 64 * j;
        const f32x4 gg = ((const f32x4*)g)[ci], bb = ((const f32x4*)b)[ci];
        const f32x4 o = v[j] * rstd * gg + bb;
        if (OUT_BF16) { u32x2 w; w.x = cvtpk(o[0], o[1]); w.y = cvtpk(o[2], o[3]); ((u32x2*)orow)[ci] = w; }
        else ((f32x4*)orow)[ci] = o;
    }
}

__device__ __forceinline__ void ln_store_h8(f32x4 (&v)[4], const float* g, const float* b, bf16_t* orow, unsigned char* orow8, int lane) {
    float s = 0.f;
#pragma unroll
    for (int j = 0; j < 4; ++j) s += (v[j].x + v[j].y) + (v[j].z + v[j].w);
    const float mean = wave_sum(s) * (1.f / D); float s2 = 0.f;
#pragma unroll
    for (int j = 0; j < 4; ++j) { v[j] = v[j] - mean; s2 += (v[j].x * v[j].x + v[j].y * v[j].y) + (v[j].z * v[j].z + v[j].w * v[j].w); }
    const float rstd = 1.f / sqrtf(wave_sum(s2) * (1.f / D) + 1e-5f);
    unsigned w8[4];
#pragma unroll
    for (int j = 0; j < 4; ++j) {
        const int ci = lane + 64 * j;
        const f32x4 gg = ((const f32x4*)g)[ci], bb = ((const f32x4*)b)[ci];
        const f32x4 o = v[j] * rstd * gg + bb;
        u32x2 w; w.x = cvtpk(o[0], o[1]); w.y = cvtpk(o[2], o[3]); ((u32x2*)orow)[ci] = w;
        int q = 0; q = __builtin_amdgcn_cvt_pk_fp8_f32(clamp8(o[0] * H8_SCALE), clamp8(o[1] * H8_SCALE), q, false); q = __builtin_amdgcn_cvt_pk_fp8_f32(clamp8(o[2] * H8_SCALE), clamp8(o[3] * H8_SCALE), q, true); w8[j] = (unsigned)q;
    }
#pragma unroll
    for (int j = 0; j < 4; ++j) ((unsigned*)orow8)[lane + 64 * j] = w8[j];
}

constexpr size_t KOFF = (size_t)NBATCH * 16 * SEQ * 64;
struct DChunk { int pat, d, r, l0, L; };
__device__ __forceinline__ DChunk dchunk(int ci) {
    DChunk c;
    if (ci < 16) { c.pat = 0; c.d = 1; c.r = 0; c.l0 = 128 * ci; c.L = 2048; }
    else if (ci < 32) { c.pat = 1; c.d = 4; c.r = (ci - 16) >> 2; c.l0 = 128 * ((ci - 16) & 3); c.L = 512; }
    else { c.pat = 2; c.d = 16; c.r = ci - 32; c.l0 = 0; c.L = 128; }
    return c;
}
__device__ __forceinline__ void dattn_stage(const bf16_t* base, const DChunk& c, LAS unsigned char* img, int wave, int lane) {
    int lb = c.l0 - 64 + (lane >> 3); asm volatile("" : "+v"(lb));
#pragma unroll
    for (int k = 0; k < 8; ++k) {
        const int inst = wave * 8 + k, rowl = 8 * (inst & 31) + (lane >> 3);
        int l = lb + 8 * (inst & 31); l = l < 0 ? 0 : (l > c.L - 1 ? c.L - 1 : l);
        const int t = c.d * l + c.r, chunk = (lane & 7) ^ ((inst < 32) ? ((rowl >> 1) & 7) : (((rowl >> 1) & 3) << 1));
        const bf16_t* src = base + ((inst < 32) ? KOFF : 2 * KOFF) + (size_t)t * 64 + chunk * 8;
        __builtin_amdgcn_global_load_lds((const unsigned*)src, (LAS unsigned*)(img + inst * 1024), 16, 0, 0);
    }
}
struct DOut { u32x2 w[4]; float lse; };
__device__ __forceinline__ void dattn_bias(f32x4 (&bias)[9], float slope_d_l2, int lane) {
    const int li = lane & 15, g = lane >> 4;
#pragma unroll
    for (int kt = 0; kt < 9; ++kt)
#pragma unroll
        for (int r = 0; r < 4; ++r) { const int rel = -64 + 16 * kt + 4 * g + r - li; bias[kt][r] = (rel >= -64 && rel <= 64) ? -slope_d_l2 * fabsf((float)rel) : -1e30f; }
}
__device__ __forceinline__ void dattn_qk(const DChunk& c, LAS const unsigned char* Kb, bf16x8 qf0, bf16x8 qf1, const f32x4 (&bias)[9], bf16x8 (&pf)[5], float& m_out, float& l_out, int wave, int lane) {
    const int g = lane >> 4;
    float sc[9][4];
    const bool edge = (c.l0 == 0) || (c.l0 + 192 > c.L);
#pragma unroll
    for (int kt = 0; kt < 9; ++kt) {
        const bf16x8 k0 = *(const LAS bf16x8*)(Kb + kt * 2048), k1 = *(const LAS bf16x8*)((LAS const unsigned char*)((unsigned)(size_t)Kb ^ 64u) + kt * 2048);
        f32x4 a = MFMA16(k0, qf0, bias[kt]); a = MFMA16(k1, qf1, a);
#pragma unroll
        for (int r = 0; r < 4; ++r) sc[kt][r] = a[r];
        if (kt % 3 == 2) __builtin_amdgcn_sched_barrier(0);
    }
    if (edge) {
#pragma unroll
        for (int kt = 0; kt < 9; ++kt)
#pragma unroll
            for (int r = 0; r < 4; ++r) { const int lk = c.l0 + 16 * wave - 64 + 16 * kt + 4 * g + r; sc[kt][r] = (lk >= 0 && lk < c.L) ? sc[kt][r] : -1e30f; }
    }
    float m = sc[0][0];
#pragma unroll
    for (int kt = 0; kt < 9; ++kt)
#pragma unroll
        for (int r = 0; r < 4; ++r) m = fmaxf(m, sc[kt][r]);
    m = fmaxf(m, __shfl_xor(m, 16)); m = fmaxf(m, __shfl_xor(m, 32));
    float l = 0.f;
#pragma unroll
    for (int kt = 0; kt < 9; ++kt)
#pragma unroll
        for (int r = 0; r < 4; ++r) { sc[kt][r] = __builtin_amdgcn_exp2f(sc[kt][r] - m); l += sc[kt][r]; }
    l += __shfl_xor(l, 16); l += __shfl_xor(l, 32);
#pragma unroll
    for (int ms = 0; ms < 5; ++ms) {
        u32x4 pw; pw.x = cvtpk(sc[2 * ms][0], sc[2 * ms][1]); pw.y = cvtpk(sc[2 * ms][2], sc[2 * ms][3]);
        if (ms < 4) { pw.z = cvtpk(sc[2 * ms + 1][0], sc[2 * ms + 1][1]); pw.w = cvtpk(sc[2 * ms + 1][2], sc[2 * ms + 1][3]); } else { pw.z = 0u; pw.w = 0u; }
        pf[ms] = __builtin_bit_cast(bf16x8, pw);
    }
    m_out = m; l_out = l;
}
__device__ __forceinline__ void dattn_pv(LAS const unsigned char* const (&Vb)[4], const bf16x8 (&pf)[5], float m, float l, LAS unsigned char* ost, LAS float* olse, int lane) {
    const int g = lane >> 4;
    f32x4 oacc[4];
#pragma unroll
    for (int et = 0; et < 4; ++et) oacc[et] = (f32x4){0.f, 0.f, 0.f, 0.f};
#pragma unroll
    for (int ms = 0; ms < 5; ++ms) {
#pragma unroll
        for (int et = 0; et < 4; ++et) {
            const s16x4 lo = vtr(Vb[et] + ms * 4096);
            s16x4 hi = (s16x4){0, 0, 0, 0};
            if (ms < 4) hi = vtr(Vb[et] + ms * 4096 + 2048);
            oacc[et] = MFMA16(cat8(lo, hi), pf[ms], oacc[et]);
        }
        __builtin_amdgcn_sched_barrier(0);
    }
    const float inv = 1.f / l;
    const int li = lane & 15;
    const float isc = inv * 16.f;
#pragma unroll
    for (int et = 0; et < 4; ++et) { int w = 0; w = __builtin_amdgcn_cvt_pk_fp8_f32(oacc[et][0] * isc, oacc[et][1] * isc, w, false); w = __builtin_amdgcn_cvt_pk_fp8_f32(oacc[et][2] * isc, oacc[et][3] * isc, w, true);
        *(LAS int*)(ost + li * 64 + ((et ^ (li & 3)) << 4) + g * 4) = w; }
    if (g == 0) olse[li] = (m + __builtin_amdgcn_logf(l)) * LN2;
}
__device__ __forceinline__ void dattn_store(const DChunk& c, LAS const unsigned char* ost, LAS const float* olse, size_t brow, int bh, bf16_t* P1, bf16_t* P2, bf16_t* P3, float* LSE, int wave, int lane) {
    unsigned char* P = (unsigned char*)(c.pat == 0 ? P1 : (c.pat == 1 ? P2 : P3));
    { const int r = lane >> 2, c4 = lane & 3; const int tq = c.d * (c.l0 + 16 * wave + r) + c.r;
      *(u32x4*)(P + ((size_t)bh * SEQ + tq) * 64 + c4 * 16) = *(const LAS u32x4*)(ost + r * 64 + ((c4 ^ (r & 3)) << 4)); }
    if (lane < 16) { const int tq = c.d * (c.l0 + 16 * wave + lane) + c.r; LSE[(size_t)c.pat * T * 16 + (size_t)bh * SEQ + tq] = olse[lane]; }
}
__device__ __forceinline__ void dattn_block(const bf16_t* QKV, bf16_t* YMIX, bf16_t* P2, bf16_t* P3, float* LSE, int bh, LAS unsigned char* lds, int wave, int lane) {
    asm volatile("" : "+v"(lane));
    const int b = bh >> 4, h = bh & 15, li = lane & 15, g = lane >> 4;
    const bf16_t* base = QKV + (size_t)bh * SEQ * 64;
    const float slope = exp2f(-0.5f * (float)(h + 1));
    DChunk cur = dchunk(0), prev = cur;
    bf16x8 qa0, qa1;
    { const int tq = cur.d * (cur.l0 + 16 * wave + li) + cur.r; qa0 = *(const bf16x8*)(base + (size_t)tq * 64 + 8 * g); qa1 = *(const bf16x8*)(base + (size_t)tq * 64 + 32 + 8 * g); }
    LAS unsigned char* ost = lds + STG_OFF + wave * 2048; LAS float* olse = (LAS float*)(lds + TAB_OFF) + wave * 16;
    f32x4 bias[9];
    dattn_bias(bias, slope * LOG2E, lane);
    const int q4 = li >> 2, p4 = li & 3, fv = ((2 * g + (q4 >> 1)) & 3) << 1;
    const unsigned kb0 = (unsigned)((16 * wave + li) * 128 + ((g ^ ((li >> 1) & 7)) << 4));
    unsigned vb0[4];
#pragma unroll
    for (int et = 0; et < 4; ++et) vb0[et] = (unsigned)(32768 + (16 * wave + 4 * g + q4) * 128 + (((2 * et) ^ fv) << 4) + ((p4 >> 1) << 4) + (p4 & 1) * 8);
    __syncthreads();
    dattn_stage(base, cur, lds, wave, lane);
    if (wave >= 4) __builtin_amdgcn_s_barrier();
#pragma unroll 1
    for (int ci = 0; ci < 48; ++ci) {
        asm volatile("s_waitcnt vmcnt(0)" ::: "memory");
        __syncthreads();
        bf16x8 qn0 = qa0, qn1 = qa1; DChunk nxt = cur;
        if (ci + 1 < 48) {
            nxt = dchunk(ci + 1);
            const int tq = nxt.d * (nxt.l0 + 16 * wave + li) + nxt.r; qn0 = *(const bf16x8*)(base + (size_t)tq * 64 + 8 * g); qn1 = *(const bf16x8*)(base + (size_t)tq * 64 + 32 + 8 * g);
        }
        if (ci > 0) dattn_store(prev, ost, olse, (size_t)b * SEQ, bh, YMIX, P2, P3, LSE, wave, lane);
        if (ci + 1 < 48) dattn_stage(base, nxt, lds + ((ci + 1) & 1) * 65536, wave, lane);
        if (ci == 16) dattn_bias(bias, slope * 4.f * LOG2E, lane); else if (ci == 32) dattn_bias(bias, slope * 16.f * LOG2E, lane);
        { LAS const unsigned char* ib = lds + (ci & 1) * 65536;
          LAS const unsigned char* const Vb[4] = {ib + vb0[0], ib + vb0[1], ib + vb0[2], ib + vb0[3]};
          bf16x8 pf[5]; float mrow, lrow;
          dattn_qk(cur, ib + kb0, qa0, qa1, bias, pf, mrow, lrow, wave, lane);
          asm volatile("s_waitcnt lgkmcnt(0)" ::: "memory"); __builtin_amdgcn_s_barrier(); asm volatile("" ::: "memory");
          dattn_pv(Vb, pf, mrow, lrow, ost, olse, lane); }
        qa0 = qn0; qa1 = qn1; prev = cur; cur = nxt;
    }
    if (wave < 4) __builtin_amdgcn_s_barrier();
    dattn_store(prev, ost, olse, (size_t)b * SEQ, bh, YMIX, P2, P3, LSE, wave, lane);
    asm volatile("s_waitcnt vmcnt(0)" ::: "memory");
    __syncthreads();
}

__device__ __forceinline__ void xattn_stage(const bf16_t* KVM, int b, int head, int quarter, LAS unsigned char* img, int wave, int lane) {
#pragma unroll
    for (int k = 0; k < 8; ++k) {
        const int inst = wave * 8 + k, row = 2 * (inst & 31) + (lane >> 5), slot = lane & 31;
        const int chunk = (inst < 32) ? (slot ^ (row & 15)) : (slot ^ ((row & 7) << 1));
        const bf16_t* src = KVM + (size_t)(b * 256 + quarter * 64 + row) * 2048 + ((inst < 32) ? 0 : 1024) + head * 256 + chunk * 8;
        __builtin_amdgcn_global_load_lds((const unsigned*)src, (LAS unsigned*)(img + inst * 1024), 16, 0, 0);
    }
}
__device__ __forceinline__ void xattn_phase(const bf16_t* QM, const bf16_t* KVM, bf16_t* XATT, LAS unsigned char* lds, int G, int vcu, int wave, int lane) {
    const int li = lane & 15, g = lane >> 4, q = li >> 2, p = li & 3;
    const int nblk = (1024 - vcu + G - 1) / G;
    if (nblk <= 0) return;
    const int niter = nblk * 4;
    bf16x8 qf[8]; f32x4 oacc[16]; float mrun = -1e30f, lrun = 0.f;
    __syncthreads();
    { const int L = vcu; xattn_stage(KVM, L >> 6, (L >> 4) & 3, 0, lds, wave, lane); }
    if (wave >= 4) __builtin_amdgcn_s_barrier();
#pragma unroll 1
    for (int it = 0; it < niter; ++it) {
        const int L = vcu + (it >> 2) * G, st = it & 3, b = L >> 6, head = (L >> 4) & 3, qblk = L & 15;
        const size_t trow = (size_t)b * SEQ + qblk * 128 + wave * 16 + li;
        if (st == 0) {
#pragma unroll
            for (int ks = 0; ks < 8; ++ks) qf[ks] = *(const bf16x8*)(QM + trow * 1024 + head * 256 + 32 * ks + 8 * g);
#pragma unroll
            for (int et = 0; et < 16; ++et) oacc[et] = (f32x4){0.f, 0.f, 0.f, 0.f};
            mrun = -1e30f; lrun = 0.f;
        }
        asm volatile("s_waitcnt vmcnt(0)" ::: "memory");
        __syncthreads();
        if (it + 1 < niter) { const int Ln = vcu + ((it + 1) >> 2) * G; xattn_stage(KVM, Ln >> 6, (Ln >> 4) & 3, (it + 1) & 3, lds + ((it + 1) & 1) * 65536, wave, lane); }
        LAS const unsigned char* Kimg = lds + (it & 1) * 65536; LAS const unsigned char* Vimg = Kimg + 32768;
        float sc[4][4];
#pragma unroll
        for (int kt = 0; kt < 4; ++kt) {
            const int rho = 16 * kt + li;
            f32x4 a = (f32x4){0.f, 0.f, 0.f, 0.f};
#pragma unroll
            for (int ks = 0; ks < 8; ++ks) a = MFMA16(*(const LAS bf16x8*)(Kimg + rho * 512 + (((4 * ks + g) ^ (rho & 15)) << 4)), qf[ks], a);
#pragma unroll
            for (int r = 0; r < 4; ++r) sc[kt][r] = a[r] * 0.0625f;
        }
        float m = sc[0][0];
#pragma unroll
        for (int kt = 0; kt < 4; ++kt)
#pragma unroll
            for (int r = 0; r < 4; ++r) m = fmaxf(m, sc[kt][r]);
        m = fmaxf(m, __shfl_xor(m, 16)); m = fmaxf(m, __shfl_xor(m, 32));
        const float mnew = fmaxf(mrun, m), alpha = __expf(mrun - mnew);
        float l = 0.f;
#pragma unroll
        for (int kt = 0; kt < 4; ++kt)
#pragma unroll
            for (int r = 0; r < 4; ++r) { sc[kt][r] = __expf(sc[kt][r] - mnew); l += sc[kt][r]; }
        l += __shfl_xor(l, 16); l += __shfl_xor(l, 32);
        lrun = lrun * alpha + l; mrun = mnew;
#pragma unroll
        for (int et = 0; et < 16; ++et) oacc[et] = oacc[et] * alpha;
        bf16x8 pf[2];
#pragma unroll
        for (int ms = 0; ms < 2; ++ms) { u32x4 pw; pw.x = cvtpk(sc[2 * ms][0], sc[2 * ms][1]); pw.y = cvtpk(sc[2 * ms][2], sc[2 * ms][3]); pw.z = cvtpk(sc[2 * ms + 1][0], sc[2 * ms + 1][1]); pw.w = cvtpk(sc[2 * ms + 1][2], sc[2 * ms + 1][3]); pf[ms] = __builtin_bit_cast(bf16x8, pw); }
        asm volatile("s_waitcnt lgkmcnt(0)" ::: "memory"); __builtin_amdgcn_s_barrier(); asm volatile("" ::: "memory");
#pragma unroll
        for (int ms = 0; ms < 2; ++ms) {
            const int rlo = 32 * ms + 4 * g + q, rhi = rlo + 16, flo = (rlo & 7) << 1, fhi = (rhi & 7) << 1;
#pragma unroll
            for (int et = 0; et < 16; ++et) {
                const int chunk = 2 * et + (p >> 1), sub = (p & 1) * 8;
                const s16x4 lo = vtr(Vimg + rlo * 512 + ((chunk ^ flo) << 4) + sub), hi = vtr(Vimg + rhi * 512 + ((chunk ^ fhi) << 4) + sub);
                oacc[et] = MFMA16(cat8(lo, hi), pf[ms], oacc[et]);
                if ((et & 3) == 3) __builtin_amdgcn_sched_barrier(0);
            }
        }
        if (st == 3) {
            const float inv = 1.f / lrun;
#pragma unroll
            for (int et = 0; et < 16; ++et) { const float i8 = inv * H8_SCALE; int w = 0; w = __builtin_amdgcn_cvt_pk_fp8_f32(clamp8(oacc[et][0] * i8), clamp8(oacc[et][1] * i8), w, false); w = __builtin_amdgcn_cvt_pk_fp8_f32(clamp8(oacc[et][2] * i8), clamp8(oacc[et][3] * i8), w, true);
                *(unsigned*)((unsigned char*)XATT + trow * 1024 + head * 256 + 16 * et + 4 * g) = (unsigned)w; }
        }
    }
    if (wave < 4) __builtin_amdgcn_s_barrier();
    asm volatile("s_waitcnt vmcnt(0)" ::: "memory");
    __syncthreads();
}

#define XB_TMO      128
#define XB_XCNT(j)  (256  + 64 * (j))
#define XB_XSUB(j)  (1280 + 64 * (j))
#define XB_XGEN(j)  (2304 + 64 * (j))
#define XB_TOP      3328
#define XB_TOPGEN   3392
#define XCD_BAR_WORDS 3456
#define XB_SPIN_CAP (1u << 18)
__device__ __forceinline__ unsigned xb_ld(unsigned* p)              { return __hip_atomic_load(p, __ATOMIC_RELAXED, __HIP_MEMORY_SCOPE_AGENT); }
__device__ __forceinline__ unsigned xb_add(unsigned* p, unsigned v) { return __hip_atomic_fetch_add(p, v, __ATOMIC_RELAXED, __HIP_MEMORY_SCOPE_AGENT); }
__device__ __forceinline__ unsigned xb_xcc_id() { return (unsigned)__builtin_amdgcn_s_getreg((3 << 11) | 20) & 0xFu; }
#define XB_SPIN(cond, bar) do { unsigned _sp = 0; while (cond) { __builtin_amdgcn_s_sleep(1); \
    if ((++_sp & 255u) == 0u) { if (xb_ld(&(bar)[XB_TMO])) break; if (_sp > XB_SPIN_CAP) { atomicAdd(&(bar)[XB_TMO], 1u); break; } } } } while (0)
struct XcdBarrier { unsigned* bar; unsigned x; volatile LAS unsigned* st; };
__device__ __forceinline__ XcdBarrier xcd_barrier_post(unsigned* bar, volatile LAS unsigned* st, int wv) {
    XcdBarrier b; b.bar = bar; b.x = xb_xcc_id(); b.st = st;
    if (wv == 0 && lane_id() == 0) (void)xb_add(&bar[XB_XCNT(b.x)], 1u);
    return b;
}
__device__ __forceinline__ void xcd_barrier_complete(unsigned* bar, unsigned x, unsigned& nloc, unsigned& nx) {
    const unsigned G = gridDim.x * gridDim.y * gridDim.z;
    unsigned sum, cnt, mine, sp = 0u;
    for (;;) {
        sum = 0u; cnt = 0u; mine = 0u;
#pragma unroll
        for (unsigned j = 0; j < 16; ++j) { const unsigned c = xb_ld(&bar[XB_XCNT(j)]); sum += c; cnt += (c > 0u) ? 1u : 0u; mine = (j == x) ? c : mine; }
        if (sum == G) break;
        __builtin_amdgcn_s_sleep(1);
        if ((++sp & 255u) == 0u) { if (xb_ld(&bar[XB_TMO])) break; if (sp > XB_SPIN_CAP) { atomicAdd(&bar[XB_TMO], 1u); break; } }
    }
    nloc = mine > 0u ? mine : 1u; nx = cnt > 0u ? cnt : 1u;
}
__device__ __forceinline__ void xcd_barrier(const XcdBarrier& b, int wv) {
    asm volatile("s_waitcnt vmcnt(0)" ::: "memory");
    __syncthreads();
    if (wv == 0 && lane_id() == 0) {
        unsigned* bar = b.bar;
        __builtin_amdgcn_s_waitcnt(0);
        unsigned nloc = b.st[0], nx = b.st[1];
        if (nloc == 0u) { xcd_barrier_complete(bar, b.x, nloc, nx); b.st[0] = nloc; b.st[1] = nx; }
        const unsigned old = xb_add(&bar[XB_XSUB(b.x)], 1u);
        const unsigned gen = old / nloc;
        if (old + 1u == (gen + 1u) * nloc) {
            __builtin_amdgcn_fence(__ATOMIC_RELEASE, "agent");
            asm volatile("s_waitcnt vmcnt(0)" ::: "memory");
            const unsigned og = xb_add(&bar[XB_TOP], 1u);
            const unsigned tg = og / nx;
            if (og + 1u == (tg + 1u) * nx) xb_add(&bar[XB_TOPGEN], 1u);
            else XB_SPIN(xb_ld(&bar[XB_TOPGEN]) == tg, bar);
            __builtin_amdgcn_fence(__ATOMIC_ACQUIRE, "agent");
            xb_add(&bar[XB_XGEN(b.x)], 1u);
            asm volatile("s_waitcnt vmcnt(0)" ::: "memory");
        } else {
            XB_SPIN(xb_ld(&bar[XB_XGEN(b.x)]) == gen, bar);
            __builtin_amdgcn_fence(__ATOMIC_ACQUIRE, "agent");
            asm volatile("s_waitcnt vmcnt(0)" ::: "memory");
        }
    }
    __syncthreads();
}

template <int PH>
__device__ __forceinline__ void run_phase(LAS unsigned char* lds, const Args& a_in, int G, int bx, int vcu, int wv) {
    constexpr int ph = (PH == 19) ? 18 : ((PH == 20) ? 13 : ((PH == 21) ? 17 : PH));
    const int NGW = G * 8, NGT = G * 512;
    typedef const __attribute__((address_space(4))) Args* KArgs;
    {
#if defined(__HIP_DEVICE_COMPILE__)
        KArgs ap = (KArgs)__builtin_amdgcn_kernarg_segment_ptr();
        asm volatile("" : "+s"(ap));
#else
        const Args* ap = &a_in;
#endif
        unsigned char* ws = ap->ws;
        int tid = wv * 64 + lane_id(); asm volatile("" : "+v"(tid));
        const int lane = tid & 63, wave = __builtin_amdgcn_readfirstlane(tid >> 6);
        const int gw = vcu * 8 + wave, gt = bx * 512 + tid;
        bf16_t* HB = (bf16_t*)(ws + WS_HB);
        int* counts = (int*)(ws + WS_CTL) + CW_COUNTS + ((PH == 20) ? 512 : 0);
        constexpr bool is_gemm = (ph == 1) || (ph == 6) || (ph == 8) || (ph == 10) || (ph == 12) || (ph == 15) || (ph == 17);
        if (is_gemm && PH_EN(1)) {
            if (ph == 15 || ph == 17) {
                LAS int* CN = (LAS int*)(lds + TAB_OFF); LAS int* TP = CN + 256; LAS int* SB = CN + 256 + 260;
                if (wave == 0) {
                    int c[4], tl[4]; int ts = 0, ss = 0;
#pragma unroll
                    for (int i = 0; i < 4; ++i) { c[i] = ld_agent(counts + 4 * lane + i); tl[i] = (c[i] + 255) >> 8; ts += tl[i]; ss += c[i]; CN[4 * lane + i] = c[i]; }
                    int xt = ts, xs = ss;
#pragma unroll
                    for (int o = 1; o < 64; o <<= 1) { const int yt = __shfl_up(xt, o), ys = __shfl_up(xs, o); if (lane >= o) { xt += yt; xs += ys; } }
                    int et = xt - ts, es = xs - ss;
#pragma unroll
                    for (int i = 0; i < 4; ++i) { TP[4 * lane + i] = et; SB[4 * lane + i] = es; et += tl[i]; es += c[i]; }
                    if (lane == 63) { TP[256] = et; SB[256] = es; }
                }
                __syncthreads();
            }
#pragma unroll
            for (int sub = 0; sub < 3; ++sub) {
                pg8::GJob j; int var = -1;
                j.M = T; j.N = 1024; j.K = 1024; j.ldo = 1024; j.alpha = DN_ALPHA;
                j.A = HB; j.Bt = nullptr; j.o0 = nullptr; j.o1 = nullptr; j.o2 = nullptr; j.o3 = nullptr; j.res = HB; j.tok = (const int*)(ws + WS_TOK); j.xA = nullptr; j.xB = nullptr; j.xO = nullptr;
                int u_lo = 0, u_hi = 1 << 30;
                if (ph == 1 && JP(1)) {
                    if (sub == 1) { __syncthreads(); convert_expert_weights(ap->in[24], ap->in[25], ap->in[26], ws, lds, vcu, NGW, wv); __syncthreads(); u_lo = bx % 8; } else if (sub == 0) u_hi = bx % 8;
                    if (sub <= 1) { var = 0; j.Bt = (const bf16_t*)(ws + WS_WIN); j.N = 3328; j.o0 = ws + WS_Z; j.o1 = ws + WS_XBC; j.o2 = ws + WS_QKV; j.o3 = ws + WS_DTRAW;
                                    j.xA = (const bf16_t*)(ws + WS_MEMB); j.xB = (const bf16_t*)(ws + WS_WK); j.xO = ws + WS_KM; }
                    else { var = 10; j.A = (const bf16_t*)(ws + WS_HB80); j.K = 512; j.Bt = (const bf16_t*)(ws + WS_WQKV8); j.N = 3072; j.o2 = ws + WS_QKV; }
                } else if (ph == 6 && JP(6)) {
                    if (sub == 0) { var = 12; j.A = (const bf16_t*)(ws + WS_YMIX); j.K = 1024; j.Bt = (const bf16_t*)(ws + WS_WOUT); j.o0 = ap->out; }
                } else if (ph == 8 && JP(8)) {
                    if (sub == 0) { var = 11; j.A = (const bf16_t*)(ws + WS_HB80); j.K = 512; j.Bt = (const bf16_t*)(ws + WS_WQ); j.o0 = ws + WS_QM; }
                } else if (ph == 10 && JP(10)) {
                    if (sub == 0) { var = 12; j.A = (const bf16_t*)(ws + WS_XATT); j.K = 512; j.Bt = (const bf16_t*)(ws + WS_WO); j.o0 = ap->out; }
                } else if (ph == 12 && JP(12)) {
                    if (sub == 0) { var = 3; j.Bt = (const bf16_t*)(ws + WS_WR); j.N = 256; j.ldo = 256; j.o0 = ws + WS_LOGITS; }
                    else if (sub == 1) { var = 4; j.Bt = (const bf16_t*)(ws + WS_WSGU); j.N = 512; j.o0 = ws + WS_HIDS; }
                } else if (ph == 15 && JP(15)) {
                    if (sub == 0) { var = 5; j.A = (const bf16_t*)(ws + WS_HB8); j.K = 512; j.Bt = (const bf16_t*)(ws + WS_WGU); j.o0 = ws + WS_HID; }
                    else if (sub == 1) { var = 2; j.A = (const bf16_t*)(ws + WS_HIDS); j.K = 256; j.Bt = (const bf16_t*)(ws + WS_WSD); j.o0 = ws + WS_PRE3; }
                } else if (ph == 17 && JP(17)) {
                    if (sub == 0) { var = 6; j.A = (const bf16_t*)(ws + WS_HID); j.K = 128; j.Bt = (const bf16_t*)(ws + WS_WD); j.o0 = ws + WS_YROWS; if (PH == 21) j.ldo = 0; }
                }
                if (var == 0) {
                    pg8::gemm_phase<0, pg8::M_PROJ, 1>(lds, j, G, bx, vcu, wv, u_lo, u_hi);
                }
                else if (var == 10) pg8::gemm_phase<0, pg8::M_PROJ, 1, 2>(lds, j, G, bx, vcu, wv);
                else if (var == 11) pg8::gemm_phase<0, pg8::M_BF16, 1, 2>(lds, j, G, bx, vcu, wv);
                else if (var == 12) pg8::gemm_phase<0, pg8::M_RESBF16, 1, 2>(lds, j, G, bx, vcu, wv);
                else if (var == 1) pg8::gemm_phase<0, pg8::M_BF16, 1>(lds, j, G, bx, vcu, wv);
                else if (var == 2) pg8::gemm_phase<0, pg8::M_RESBF16, 1>(lds, j, G, bx, vcu, wv);
                else if (var == 3) pg8::gemm_phase<0, pg8::M_F32, 0>(lds, j, G, bx, vcu, wv);
                else if (var == 4) pg8::gemm_phase<0, pg8::M_GATEUP, 1>(lds, j, G, bx, vcu, wv);
                else if (var == 5) pg8::gemm_phase<1, pg8::M_GATEUP8, 1, 1>(lds, j, G, bx, vcu, wv);
                else if (var == 6) pg8::gemm_phase<2, pg8::M_FP8ROWS, 1, 2>(lds, j, G, bx, vcu, wv);
            }
        } else if (ph == 0 && PH_EN(0)) {
            LAS float* scr = (LAS float*)(lds + wave * (64 * 65 * 4));
            int off = 0;
            TrJob j; j.map = 0; j.p0 = 0;
            j.W = ap->in[4]; j.WT = (bf16_t*)(ws + WS_WIN); j.ldw = 6176; j.ncols = 6176; j.K = 1024; j.ldt = 1024; j.map = 1; tr_run<true>(j, 1, 0, 0, scr, gw, NGW, lane, off);
            j.map = 0;
            { TrJob j8 = j; j8.W = ap->in[4] + 3104; j8.WT = (bf16_t*)(ws + WS_WQKV8); j8.ncols = 3072; tr_run<false, true>(j8, 1, 0, 0, scr, gw, NGW, lane, off); }
            j.W = ap->in[13]; j.WT = (bf16_t*)(ws + WS_WOUT); j.ldw = 1024; j.ncols = 1024; j.K = 2048; j.ldt = 2048; tr_run<false, true>(j, 1, 0, 0, scr, gw, NGW, lane, off);
            j.K = 1024; j.ldt = 1024;
            j.W = ap->in[16]; j.WT = (bf16_t*)(ws + WS_WQ); tr_run<false, true>(j, 1, 0, 0, scr, gw, NGW, lane, off);
            j.W = ap->in[17]; j.WT = (bf16_t*)(ws + WS_WK); tr_run(j, 1, 0, 0, scr, gw, NGW, lane, off);
            j.W = ap->in[18]; j.WT = (bf16_t*)(ws + WS_WV); tr_run(j, 1, 0, 0, scr, gw, NGW, lane, off);
            j.W = ap->in[19]; j.WT = (bf16_t*)(ws + WS_WO); tr_run<false, true>(j, 1, 0, 0, scr, gw, NGW, lane, off);
            j.W = ap->in[22]; j.WT = (bf16_t*)(ws + WS_WR); j.ldw = 256; j.ncols = 256; tr_run(j, 1, 0, 0, scr, gw, NGW, lane, off);
            j.map = 2;
            j.W = ap->in[27]; j.WT = (bf16_t*)(ws + WS_WSGU); j.p0 = 0; tr_run(j, 1, 0, 0, scr, gw, NGW, lane, off);
            j.W = ap->in[28]; j.p0 = 32; tr_run(j, 1, 0, 0, scr, gw, NGW, lane, off);
            j.map = 0; j.p0 = 0;
            j.W = ap->in[29]; j.WT = (bf16_t*)(ws + WS_WSD); j.ldw = 1024; j.ncols = 1024; j.K = 256; j.ldt = 256; tr_run(j, 1, 0, 0, scr, gw, NGW, lane, off);
            { u32x4* z = (u32x4*)((bf16_t*)(ws + WS_WIN) + (size_t)6176 * 1024); const int n16 = 224 * 1024 * 2 / 16; for (int i = gt; i < n16; i += NGT) z[i] = (u32x4){0u, 0u, 0u, 0u}; }
            { const f32x4* s = (const f32x4*)ap->in[1]; u32x2* dd = (u32x2*)(ws + WS_MEMB); const int n4 = 4096 * 1024 / 4;
#pragma unroll 8
              for (int i = gt; i < n4; i += NGT) { const f32x4 v = s[i]; u32x2 w; w.x = cvtpk(v[0], v[1]); w.y = cvtpk(v[2], v[3]); dd[i] = w; } }
            for (int m = gw; m < T; m += NGW) {
                const f32x4* xr = (const f32x4*)(ap->in[0] + (size_t)m * D) + lane; f32x4 v[4];
#pragma unroll
                for (int jx = 0; jx < 4; ++jx) v[jx] = xr[64 * jx];
                ln_store_h8(v, ap->in[2], ap->in[3], HB + (size_t)m * D, ws + WS_HB80 + (size_t)m * D, lane);
            }
        } else if (ph == 2 && PH_EN(2)) {
            {
                const bf16_t* XBC = (const bf16_t*)(ws + WS_XBC); bf16_t* XBCA = (bf16_t*)((unsigned char*)ap->out);
                const int c8 = gt & 255; float w[5][8], bs[8];
#pragma unroll
                for (int k = 0; k < 5; ++k)
#pragma unroll
                    for (int jx = 0; jx < 8; ++jx) w[k][jx] = ap->in[5][k * 2048 + c8 * 8 + jx];
#pragma unroll
                for (int jx = 0; jx < 8; ++jx) bs[jx] = ap->in[6][c8 * 8 + jx];
                {
                    const int tb = (bx * 2 + (tid >> 8)) * 64;
                    const int s0 = tb & (SEQ - 1);
                    u32x4 rw[12];
#pragma unroll
                    for (int k = 0; k < 4; ++k) { const int ss = s0 + k - 2; rw[8 + k] = (ss >= 0 && ss < SEQ) ? *(const u32x4*)(XBC + (size_t)(tb + k - 2) * 2048 + c8 * 8) : (u32x4){0u, 0u, 0u, 0u}; }
#pragma unroll 1
                    for (int i0 = 0; i0 < 64; i0 += 8) {
#pragma unroll
                        for (int k = 0; k < 4; ++k) rw[k] = rw[8 + k];
#pragma unroll
                        for (int k = 0; k < 8; ++k) { const int ss = s0 + i0 + 2 + k; rw[4 + k] = (ss < SEQ) ? *(const u32x4*)(XBC + (size_t)(tb + i0 + 2 + k) * 2048 + c8 * 8) : (u32x4){0u, 0u, 0u, 0u}; }
#pragma unroll
                        for (int i = 0; i < 8; ++i) {
                            float acc[8];
#pragma unroll
                            for (int jx = 0; jx < 8; ++jx) acc[jx] = bs[jx];
#pragma unroll
                            for (int k = 0; k < 5; ++k) { const u32x4 v = rw[i + k];
                                acc[0] += w[k][0] * bflo(v.x); acc[1] += w[k][1] * bfhi(v.x); acc[2] += w[k][2] * bflo(v.y); acc[3] += w[k][3] * bfhi(v.y);
                                acc[4] += w[k][4] * bflo(v.z); acc[5] += w[k][5] * bfhi(v.z); acc[6] += w[k][6] * bflo(v.w); acc[7] += w[k][7] * bfhi(v.w); }
                            u32x4 o; o.x = cvtpk(siluf(acc[0]), siluf(acc[1])); o.y = cvtpk(siluf(acc[2]), siluf(acc[3])); o.z = cvtpk(siluf(acc[4]), siluf(acc[5])); o.w = cvtpk(siluf(acc[6]), siluf(acc[7]));
                            *(u32x4*)(XBCA + (size_t)(tb + i0 + i) * 2048 + c8 * 8) = o;
                        }
                    }
                }
                const float* DTRAW = (const float*)(ws + WS_DTRAW); float* DTF = (float*)(ws + WS_DTF); float* DTB = (float*)(ws + WS_DTB);
                for (int i = gt; i < T * 16; i += NGT) { const int t = i >> 4, h = i & 15;
                    const float xf = DTRAW[t * 32 + h] + ap->in[7][h], xb = DTRAW[t * 32 + 16 + h] + ap->in[8][h];
                    const int o = (((t >> 7) * 16) + h) * 128 + (t & 127);
                    DTF[o] = fmaxf(xf, 0.f) + log1pf(__expf(-fabsf(xf))); DTB[o] = fmaxf(xb, 0.f) + log1pf(__expf(-fabsf(xb))); }
            }
#ifdef DUP_DATTN
            for (int bh = vcu; bh < 256; bh += G)
                dattn_block((const bf16_t*)(ws + WS_QKV), (bf16_t*)(ws + WS_ATTP1), (bf16_t*)(ws + WS_ATTP2), (bf16_t*)(ws + WS_ATTP3), (float*)(ws + WS_LSE), bh, lds, wave, lane);
#endif
            for (int bh = vcu; bh < 256; bh += G)
                dattn_block((const bf16_t*)(ws + WS_QKV), (bf16_t*)(ws + WS_ATTP1), (bf16_t*)(ws + WS_ATTP2), (bf16_t*)(ws + WS_ATTP3), (float*)(ws + WS_LSE), bh, lds, wave, lane);
        } else if (ph == 3 && PH_EN(3)) {
            const bf16_t* XBCA = (const bf16_t*)((unsigned char*)ap->out);
            const float* DTF = (const float*)(ws + WS_DTF); const float* DTB = (const float*)(ws + WS_DTB);
            float* ECSF = (float*)(ws + WS_ECSF); float* ECSB = (float*)(ws + WS_ECSB); float* DEC = (float*)(ws + WS_DEC);
            bf16_t* YSSD = (bf16_t*)(ws + WS_YSSD); bf16_t* STATES = (bf16_t*)(ws + WS_STATES);
            constexpr int BM_OFF = 0, BM_P = 288, XH_OFF = 36864, XH_P = 160, XHF_OFF = XH_OFF + 20480, XHB_OFF = XHF_OFF + 20480, ARR_OFF = XHB_OFF + 20480,
                          ST_OFF = ARR_OFF + 4 * 3072, ST_P = 272, YS_OFF = XHF_OFF, YS_P = 272;
            const int li = lane & 15, g4 = lane >> 4;
            for (int L = vcu; L < 1024; L += G) {
                const int b = L >> 6, c = (L >> 2) & 15, grp = L & 3;
                const size_t t0 = (size_t)b * SEQ + c * 128;
                __syncthreads();
#pragma unroll
                for (int ps = 0; ps < 4; ++ps) { const int sI = ps * 32 + (tid >> 4), ch = tid & 15;
                    *(LAS u32x4*)(lds + BM_OFF + sI * BM_P + ch * 16) = *(const u32x4*)(XBCA + (t0 + sI) * 2048 + 1024 + grp * 128 + ch * 8); }
                bf16x8 cf[4];
#pragma unroll
                for (int ks = 0; ks < 4; ++ks) cf[ks] = *(const bf16x8*)(XBCA + (t0 + 16 * wave + li) * 2048 + 1536 + grp * 128 + 32 * ks + 8 * g4);
                if (wave < 4) {
                        const int hh = wave, h = grp * 4 + hh; const size_t hc = ((size_t)(b * 16 + c) * 16 + h) * 128;
                        LAS float* csf = (LAS float*)(lds + ARR_OFF) + hh * 768; LAS float* csb = csf + 128; LAS float* dtfa = csf + 256; LAS float* dtba = csf + 384; LAS float* wfa = csf + 512; LAS float* wba = csf + 640;
                        const float af = -__expf(ap->in[9][h]), ab = -__expf(ap->in[10][h]);
                        const int s0 = 2 * lane;
                        const f32x2 dfv = *(const f32x2*)(DTF + hc + s0), dbv = *(const f32x2*)(DTB + hc + s0);
                        const float df0 = dfv.x, df1 = dfv.y, db0 = dbv.x, db1 = dbv.y;
                        const float pf_ = (df0 + df1) * af, pb_ = (db0 + db1) * ab;
                        float xf = pf_, xb = pb_;
#pragma unroll
                        for (int o = 1; o < 64; o <<= 1) { const float yf = __shfl_up(xf, o), yb = __shfl_up(xb, o); if (lane >= o) { xf += yf; xb += yb; } }
                        const float totf = __shfl(xf, 63), totb = __shfl(xb, 63);
                        const float ef = xf - pf_, eb = xb - pb_;
                        const float cf0 = ef + df0 * af, cf1 = ef + pf_;
                        const float cb0 = totb - eb, cb1 = totb - eb - db0 * ab;
                        csf[s0] = cf0; csf[s0 + 1] = cf1; csb[s0] = cb0; csb[s0 + 1] = cb1; dtfa[s0] = df0; dtfa[s0 + 1] = df1; dtba[s0] = db0; dtba[s0 + 1] = db1;
                        wfa[s0] = df0 * __expf(totf - cf0); wfa[s0 + 1] = df1 * __expf(totf - cf1); wba[s0] = db0 * __expf(totb - cb0); wba[s0 + 1] = db1 * __expf(totb - cb1);
                        *(f32x2*)(ECSF + hc + s0) = (f32x2){__expf(cf0), __expf(cf1)}; *(f32x2*)(ECSB + hc + s0) = (f32x2){__expf(cb0), __expf(cb1)};
                        if (lane == 0) { DEC[((b * 16 + c) * 16 + h) * 2 + 0] = __expf(totf); DEC[((b * 16 + c) * 16 + h) * 2 + 1] = __expf(totb); }
                    }
                __syncthreads();
                f32x4 cbt[8];
#pragma unroll
                for (int st = 0; st < 8; ++st) { f32x4 acc = (f32x4){0.f, 0.f, 0.f, 0.f};
#pragma unroll
                    for (int ks = 0; ks < 4; ++ks) acc = MFMA16(*(const LAS bf16x8*)(lds + BM_OFF + (16 * st + li) * BM_P + (32 * ks + 8 * g4) * 2), cf[ks], acc);
                    cbt[st] = acc; }
                u32x4 xpre[2];
#pragma unroll
                for (int ps = 0; ps < 2; ++ps) { const int id = ps * 512 + tid, sI = id >> 3, ch = id & 7; xpre[ps] = *(const u32x4*)(XBCA + (t0 + sI) * 2048 + grp * 256 + ch * 8); }
                for (int hh = 0; hh < 4; ++hh) {
                    const int h = grp * 4 + hh;
                    const size_t hc = ((size_t)(b * 16 + c) * 16 + h) * 128;
                    LAS float* csf = (LAS float*)(lds + ARR_OFF) + hh * 768; LAS float* csb = csf + 128; LAS float* dtfa = csf + 256; LAS float* dtba = csf + 384; LAS float* wfa = csf + 512; LAS float* wba = csf + 640;
                    __syncthreads();
#pragma unroll
                    for (int ps = 0; ps < 2; ++ps) { const int id = ps * 512 + tid, sI = id >> 3, ch = id & 7;
                        *(LAS u32x4*)(lds + XH_OFF + sI * XH_P + ch * 16) = xpre[ps]; }
                    __syncthreads();
                    if (hh < 3) {
#pragma unroll
                        for (int ps = 0; ps < 2; ++ps) { const int id = ps * 512 + tid, sI = id >> 3, ch = id & 7; xpre[ps] = *(const u32x4*)(XBCA + (t0 + sI) * 2048 + (h + 1) * 64 + ch * 8); }
                    }
#pragma unroll
                    for (int ps = 0; ps < 2; ++ps) { const int id = ps * 512 + tid, sI = id >> 3, ch = id & 7;
                        const u32x4 v = *(const LAS u32x4*)(lds + XH_OFF + sI * XH_P + ch * 16); const float wf = wfa[sI], wb = wba[sI];
                        u32x4 of, ob;
                        of.x = cvtpk(bflo(v.x) * wf, bfhi(v.x) * wf); of.y = cvtpk(bflo(v.y) * wf, bfhi(v.y) * wf); of.z = cvtpk(bflo(v.z) * wf, bfhi(v.z) * wf); of.w = cvtpk(bflo(v.w) * wf, bfhi(v.w) * wf);
                        ob.x = cvtpk(bflo(v.x) * wb, bfhi(v.x) * wb); ob.y = cvtpk(bflo(v.y) * wb, bfhi(v.y) * wb); ob.z = cvtpk(bflo(v.z) * wb, bfhi(v.z) * wb); ob.w = cvtpk(bflo(v.w) * wb, bfhi(v.w) * wb);
                        *(LAS u32x4*)(lds + XHF_OFF + sI * XH_P + ch * 16) = of; *(LAS u32x4*)(lds + XHB_OFF + sI * XH_P + ch * 16) = ob; }
                    __syncthreads();
                    const int q = li >> 2, p = li & 3;
#pragma unroll 1
                    for (int k = 0; k < 8; ++k) {
                        const int dir = wave >> 2, ntile = (wave & 3) * 2 + (k >> 2), pt = k & 3;
                        const int xoff = dir ? XHB_OFF : XHF_OFF;
                        f32x4 acc = (f32x4){0.f, 0.f, 0.f, 0.f};
#pragma unroll
                        for (int ks = 0; ks < 4; ++ks) {
                            const int rb = 32 * ks + 8 * g4 + q;
                            const s16x4 alo = vtr(lds + BM_OFF + rb * BM_P + (16 * ntile + 4 * p) * 2), ahi = vtr(lds + BM_OFF + (rb + 4) * BM_P + (16 * ntile + 4 * p) * 2);
                            const s16x4 blo = vtr(lds + xoff + rb * XH_P + (16 * pt + 4 * p) * 2), bhi = vtr(lds + xoff + (rb + 4) * XH_P + (16 * pt + 4 * p) * 2);
                            acc = MFMA16(cat8(alo, ahi), cat8(blo, bhi), acc);
                        }
                        u32x2 w; w.x = cvtpk(acc[0], acc[1]); w.y = cvtpk(acc[2], acc[3]);
                        *(LAS u32x2*)(lds + ST_OFF + (dir * 64 + 16 * pt + li) * ST_P + (16 * ntile + 4 * g4) * 2) = w;
                    }
                    __syncthreads();
                    {
                        const int tl = 16 * wave + li; const float cft = csf[tl], cbt_t = csb[tl];
                        f32x4 yacc[4];
#pragma unroll
                        for (int pt = 0; pt < 4; ++pt) yacc[pt] = (f32x4){0.f, 0.f, 0.f, 0.f};
#pragma unroll
                        for (int k2 = 0; k2 < 4; ++k2) {
                            float mv[8];
#pragma unroll
                            for (int half = 0; half < 2; ++half) {
                                const int st = 2 * k2 + half, sb = 16 * st + 4 * g4;
                                const f32x4 c4f = *(const LAS f32x4*)(csf + sb), c4b = *(const LAS f32x4*)(csb + sb), d4f = *(const LAS f32x4*)(dtfa + sb), d4b = *(const LAS f32x4*)(dtba + sb);
#pragma unroll
                                for (int r = 0; r < 4; ++r) { const int sI = sb + r;
                                    const float lf = (sI <= tl) ? __expf(cft - c4f[r]) * d4f[r] : 0.f, lb = (sI >= tl) ? __expf(cbt_t - c4b[r]) * d4b[r] : 0.f;
                                    mv[half * 4 + r] = cbt[st][r] * (lf + lb); }
                            }
                            u32x4 aw; aw.x = cvtpk(mv[0], mv[1]); aw.y = cvtpk(mv[2], mv[3]); aw.z = cvtpk(mv[4], mv[5]); aw.w = cvtpk(mv[6], mv[7]);
                            const bf16x8 af8 = __builtin_bit_cast(bf16x8, aw);
#pragma unroll
                            for (int pt = 0; pt < 4; ++pt) {
                                const s16x4 lo = vtr(lds + XH_OFF + (32 * k2 + 4 * g4 + q) * XH_P + (16 * pt + 4 * p) * 2), hi = vtr(lds + XH_OFF + (32 * k2 + 16 + 4 * g4 + q) * XH_P + (16 * pt + 4 * p) * 2);
                                yacc[pt] = MFMA16(cat8(lo, hi), af8, yacc[pt]);
                            }
                        }
#pragma unroll
                        for (int pt = 0; pt < 4; ++pt) *(LAS f32x4*)(lds + YS_OFF + tl * YS_P + (16 * pt + 4 * g4) * 4) = yacc[pt];
                    }
#pragma unroll
                    for (int ps = 0; ps < 4; ++ps) { const int id = ps * 512 + tid, dir = id >> 10, fc = id & 1023, row = 16 * (fc >> 8) + (fc & 15), n0 = 32 * ((fc >> 6) & 3) + 8 * ((fc >> 4) & 3);
                        *(u32x4*)(STATES + ((hc / 128) * 2 + dir) * 8192 + fc * 8) = *(const LAS u32x4*)(lds + ST_OFF + (dir * 64 + row) * ST_P + n0 * 2); }
                    __syncthreads();
                    const float dsk = ap->in[11][h];
#pragma unroll
                    for (int ps = 0; ps < 2; ++ps) { const int f2 = ps * 512 + tid;
                        u32x4 ow;
#pragma unroll
                        for (int e = 0; e < 2; ++e) { const int fc = 2 * f2 + e, row = 16 * (fc >> 8) + (fc & 15), p0 = 16 * ((fc >> 6) & 3) + 4 * ((fc >> 4) & 3);
                            f32x4 o = *(const LAS f32x4*)(lds + YS_OFF + row * YS_P + p0 * 4);
                            const u32x2 xw = *(const LAS u32x2*)(lds + XH_OFF + row * XH_P + p0 * 2);
                            o[0] += dsk * bflo(xw.x); o[1] += dsk * bfhi(xw.x); o[2] += dsk * bflo(xw.y); o[3] += dsk * bfhi(xw.y);
                            if (e == 0) { ow.x = cvtpk(o[0], o[1]); ow.y = cvtpk(o[2], o[3]); } else { ow.z = cvtpk(o[0], o[1]); ow.w = cvtpk(o[2], o[3]); } }
                        *(u32x4*)(YSSD + hc * 64 + (size_t)f2 * 8) = ow; }
                }
            }
        } else if (ph == 4 && PH_EN(4)) {
            bf16_t* STATES = (bf16_t*)(ws + WS_STATES); const float* DEC = (const float*)(ws + WS_DEC);
            for (int task = gt; task < 16 * 16 * 2 * 64 * 16; task += NGT) {
                const int n8 = task & 15, p = (task >> 4) & 63, dir = (task >> 10) & 1, h = (task >> 11) & 15, b = task >> 15;
                float hs[8];
#pragma unroll
                for (int i = 0; i < 8; ++i) hs[i] = 0.f;
#pragma unroll
                for (int step = 0; step < 16; ++step) {
                    const int c = dir ? 15 - step : step;
                    u32x4* ptr = (u32x4*)(STATES + ((((size_t)(b * 16 + c) * 16 + h) * 2 + dir) * 64 + p) * 128 + n8 * 8);
                    const u32x4 s = *ptr; const float dc = DEC[((b * 16 + c) * 16 + h) * 2 + dir];
                    u32x4 o; o.x = cvtpk(hs[0], hs[1]); o.y = cvtpk(hs[2], hs[3]); o.z = cvtpk(hs[4], hs[5]); o.w = cvtpk(hs[6], hs[7]); *ptr = o;
                    hs[0] = hs[0] * dc + bflo(s.x); hs[1] = hs[1] * dc + bfhi(s.x); hs[2] = hs[2] * dc + bflo(s.y); hs[3] = hs[3] * dc + bfhi(s.y);
                    hs[4] = hs[4] * dc + bflo(s.z); hs[5] = hs[5] * dc + bfhi(s.z); hs[6] = hs[6] * dc + bflo(s.w); hs[7] = hs[7] * dc + bfhi(s.w);
                }
            }
        } else if (ph == 5 && PH_EN(5)) {
            const bf16_t* XBCA = (const bf16_t*)((unsigned char*)ap->out); const bf16_t* PREV = (const bf16_t*)(ws + WS_STATES); const bf16_t* Z = (const bf16_t*)(ws + WS_Z);
            const float* ECSF = (const float*)(ws + WS_ECSF); const float* ECSB = (const float*)(ws + WS_ECSB); const bf16_t* YSSD = (const bf16_t*)(ws + WS_YSSD);
            bf16_t* YMIX = (bf16_t*)(ws + WS_YMIX); const bf16_t* P1 = (const bf16_t*)(ws + WS_ATTP1); const bf16_t* P2 = (const bf16_t*)(ws + WS_ATTP2); const bf16_t* P3 = (const bf16_t*)(ws + WS_ATTP3); const float* LSE = (const float*)(ws + WS_LSE);
            constexpr int GP = 2056, SSQ_OFF = 64 * GP;
            LAS float* SSQ = (LAS float*)(lds + SSQ_OFF);
            const int li = lane & 15, g4 = lane >> 4, tt = wave & 3, hh2 = wave >> 2;
            for (int L = vcu; L < 512; L += G) {
                const int b = L >> 5, c = (L >> 1) & 15, hf = L & 1;
                const size_t t0 = (size_t)b * SEQ + c * 128 + hf * 64;
                __syncthreads();
                float ssq = 0.f;
                const size_t tme = t0 + 16 * tt + li;
                for (int gi = 0; gi < 2; ++gi) {
                    const int grp = hh2 * 2 + gi;
                    bf16x8 cf[4];
#pragma unroll
                    for (int ks = 0; ks < 4; ++ks) cf[ks] = *(const bf16x8*)(XBCA + tme * 2048 + 1536 + grp * 128 + 32 * ks + 8 * g4);
                    for (int hx = 0; hx < 4; ++hx) {
                        const int h = grp * 4 + hx;
                        const size_t ei = ((size_t)(b * 16 + c) * 16 + h) * 128 + hf * 64 + 16 * tt + li; const float ef = ECSF[ei], eb = ECSB[ei];
#pragma unroll
                        for (int pt = 0; pt < 4; ++pt) {
                            f32x4 af = (f32x4){0.f, 0.f, 0.f, 0.f}, ab = (f32x4){0.f, 0.f, 0.f, 0.f};
                            const size_t hcx = (size_t)(b * 16 + c) * 16 + h;
                            const bf16_t* pf = PREV + hcx * 2 * 8192 + (pt * 4 * 64 + lane) * 8;
#pragma unroll
                            for (int ks = 0; ks < 4; ++ks) { af = MFMA16(*(const bf16x8*)(pf + ks * 512), cf[ks], af); ab = MFMA16(*(const bf16x8*)(pf + 8192 + ks * 512), cf[ks], ab); }
                            const int col = h * 64 + 16 * pt + 4 * g4;
                            const u32x2 yw = *(const u32x2*)(YSSD + hcx * 8192 + (((hf * 4 + tt) * 4 + pt) * 64 + lane) * 4); const f32x4 yd = (f32x4){bflo(yw.x), bfhi(yw.x), bflo(yw.y), bfhi(yw.y)};
                            const u32x2 zw = *(const u32x2*)(Z + tme * 1024 + col);
                            float gv[4];
                            gv[0] = (yd[0] + ef * af[0] + eb * ab[0]) * siluf(bflo(zw.x)); gv[1] = (yd[1] + ef * af[1] + eb * ab[1]) * siluf(bfhi(zw.x));
                            gv[2] = (yd[2] + ef * af[2] + eb * ab[2]) * siluf(bflo(zw.y)); gv[3] = (yd[3] + ef * af[3] + eb * ab[3]) * siluf(bfhi(zw.y));
                            ssq += (gv[0] * gv[0] + gv[1] * gv[1]) + (gv[2] * gv[2] + gv[3] * gv[3]);
                            u32x2 w; w.x = cvtpk(gv[0], gv[1]); w.y = cvtpk(gv[2], gv[3]);
                            *(LAS u32x2*)(lds + (16 * tt + li) * GP + col * 2) = w;
                        }
                    }
                }
                ssq += __shfl_xor(ssq, 16); ssq += __shfl_xor(ssq, 32);
                if (g4 == 0) SSQ[hh2 * 64 + 16 * tt + li] = ssq;
                __syncthreads();
#pragma unroll 4
                for (int k = 0; k < 16; ++k) {
                    const int id = tid + 512 * k, row = id >> 7, ch = id & 127;
                    const float rstd = 1.f / sqrtf((SSQ[row] + SSQ[64 + row]) * (1.f / 1024.f) + 1e-5f);
                    const u32x2 lo = *(const LAS u32x2*)(lds + row * GP + ch * 16), hi = *(const LAS u32x2*)(lds + row * GP + ch * 16 + 8);
                    const f32x4 w0 = *(const f32x4*)(ap->in[12] + ch * 8), w1 = *(const f32x4*)(ap->in[12] + ch * 8 + 4);
                    const float rs = rstd * H8_SCALE; int q0 = 0, q1 = 0;
                    q0 = __builtin_amdgcn_cvt_pk_fp8_f32(clamp8(bflo(lo.x) * rs * w0[0]), clamp8(bfhi(lo.x) * rs * w0[1]), q0, false); q0 = __builtin_amdgcn_cvt_pk_fp8_f32(clamp8(bflo(lo.y) * rs * w0[2]), clamp8(bfhi(lo.y) * rs * w0[3]), q0, true);
                    q1 = __builtin_amdgcn_cvt_pk_fp8_f32(clamp8(bflo(hi.x) * rs * w1[0]), clamp8(bfhi(hi.x) * rs * w1[1]), q1, false); q1 = __builtin_amdgcn_cvt_pk_fp8_f32(clamp8(bflo(hi.y) * rs * w1[2]), clamp8(bfhi(hi.y) * rs * w1[3]), q1, true);
                    u32x2 o; o.x = (unsigned)q0; o.y = (unsigned)q1;
                    *(u32x2*)((unsigned char*)YMIX + (t0 + row) * 2048 + ch * 8) = o;
                }
#pragma unroll 4
                for (int k = 0; k < 8; ++k) {
                    const int id = tid + 512 * k, row = id >> 6, hd = (id >> 2) & 15, ec = id & 3; const size_t t = t0 + row;
                    const size_t li_ = ((size_t)(b * 16 + hd)) * SEQ + (t - (size_t)b * SEQ); const float l1 = LSE[li_], l2 = LSE[(size_t)T * 16 + li_], l3 = LSE[(size_t)2 * T * 16 + li_];
                    const float mx = fmaxf(l1, fmaxf(l2, l3)); float w1 = __expf(l1 - mx), w2 = __expf(l2 - mx), w3 = __expf(l3 - mx); const float iw = (H8_SCALE / 16.f) / (w1 + w2 + w3); w1 *= iw; w2 *= iw; w3 *= iw;
                    const size_t po = li_ * 64 + ec * 16;
                    const u32x4 o1 = *(const u32x4*)((const unsigned char*)P1 + po), o2 = *(const u32x4*)((const unsigned char*)P2 + po), o3 = *(const u32x4*)((const unsigned char*)P3 + po);
                    u32x4 oa;
#pragma unroll
                    for (int q4 = 0; q4 < 4; ++q4) {
                        const f32x2 a0 = __builtin_amdgcn_cvt_pk_f32_fp8((int)o1[q4], false), a1 = __builtin_amdgcn_cvt_pk_f32_fp8((int)o1[q4], true);
                        const f32x2 b0 = __builtin_amdgcn_cvt_pk_f32_fp8((int)o2[q4], false), b1 = __builtin_amdgcn_cvt_pk_f32_fp8((int)o2[q4], true);
                        const f32x2 c0 = __builtin_amdgcn_cvt_pk_f32_fp8((int)o3[q4], false), c1 = __builtin_amdgcn_cvt_pk_f32_fp8((int)o3[q4], true);
                        int qw = 0;
                        qw = __builtin_amdgcn_cvt_pk_fp8_f32(clamp8(w1 * a0.x + w2 * b0.x + w3 * c0.x), clamp8(w1 * a0.y + w2 * b0.y + w3 * c0.y), qw, false);
                        qw = __builtin_amdgcn_cvt_pk_fp8_f32(clamp8(w1 * a1.x + w2 * b1.x + w3 * c1.x), clamp8(w1 * a1.y + w2 * b1.y + w3 * c1.y), qw, true);
                        oa[q4] = (unsigned)qw;
                    }
                    *(u32x4*)((unsigned char*)YMIX + t * 2048 + 1024 + hd * 64 + ec * 16) = oa;
                }
            }
        } else if ((ph == 7 || ph == 11) && PH_EN(7)) {
            const float* gp = ph == 7 ? ap->in[14] : ap->in[20]; const float* bp = ph == 7 ? ap->in[15] : ap->in[21];
            for (int m = gw; m < T; m += NGW) {
                const u32x2* xr = (const u32x2*)((const bf16_t*)ap->out + (size_t)m * D) + lane; f32x4 v[4];
#pragma unroll
                for (int jx = 0; jx < 4; ++jx) { const u32x2 w = xr[64 * jx]; v[jx] = (f32x4){bflo(w.x), bfhi(w.x), bflo(w.y), bfhi(w.y)}; }
                ln_store_h8(v, gp, bp, HB + (size_t)m * D, ws + (ph == 11 ? WS_HB8 : WS_HB80) + (size_t)m * D, lane);
            }
        } else if (ph == 9 && PH_EN(9)) {
            xattn_phase((const bf16_t*)(ws + WS_QM), (const bf16_t*)(ws + WS_KM), (bf16_t*)(ws + WS_XATT), lds, G, vcu, wave, lane);
        } else if (ph == 13 && PH_EN(13)) {
            const float* LOG = (const float*)(ws + WS_LOGITS); int* EIDX = (int*)(ws + WS_EIDX); int* POS = (int*)(ws + WS_POS); float* GATE = (float*)(ws + WS_GATE);
            int* BH = (int*)(ws + WS_BH) + ((PH == 20) ? 65536 : 0);
            LAS int* hist = (LAS int*)(lds + TAB_OFF);
            __syncthreads();
            if (tid < 256) hist[tid] = 0;
            __syncthreads();
            const f32x4 rb = *(const f32x4*)(ap->in[23] + 4 * lane);
            for (int t = gw; t < T; t += NGW) {
                const f32x4 lg = *(const f32x4*)(LOG + (size_t)t * 256 + 4 * lane);
                float s[4], c[4];
#pragma unroll
                for (int i = 0; i < 4; ++i) { s[i] = 1.f / (1.f + __expf(-lg[i])); c[i] = s[i] + rb[i]; }
                float ta = fmaxf(fmaxf(c[0], c[1]), fmaxf(c[2], c[3]));
                float tb;
                { const float m01 = fmaxf(c[0], c[1]), n01 = fminf(c[0], c[1]), m23 = fmaxf(c[2], c[3]), n23 = fminf(c[2], c[3]); tb = fmaxf(fminf(m01, m23), fmaxf(n01, n23)); }
#pragma unroll
                for (int o = 1; o < 8; o <<= 1) { const float oa = __shfl_xor(ta, o), ob = __shfl_xor(tb, o); const float na = fmaxf(ta, oa), nb = fmaxf(fminf(ta, oa), fmaxf(tb, ob)); ta = na; tb = nb; }
                const float gs = ta + tb; const int myg = lane >> 3;
                int rank = 0;
#pragma unroll
                for (int jx = 0; jx < 8; ++jx) { const float o = __builtin_bit_cast(float, __builtin_amdgcn_readlane(__builtin_bit_cast(int, gs), 8 * jx)); rank += (o > gs || (o == gs && jx < myg)) ? 1 : 0; }
                const bool sel = rank < 4;
                float h[4]; int hi_[4]; float hs[4];
#pragma unroll
                for (int i = 0; i < 4; ++i) { h[i] = sel ? c[i] : -1e30f; hi_[i] = 4 * lane + i; hs[i] = s[i]; }
#define CEX(x, y) do { const bool sw = (h[y] > h[x]); const float tv = sw ? h[y] : h[x], uv = sw ? h[x] : h[y]; const int ti = sw ? hi_[y] : hi_[x], ui = sw ? hi_[x] : hi_[y]; \
                       const float tsv = sw ? hs[y] : hs[x], usv = sw ? hs[x] : hs[y]; h[x] = tv; h[y] = uv; hi_[x] = ti; hi_[y] = ui; hs[x] = tsv; hs[y] = usv; } while (0)
                CEX(0, 1); CEX(2, 3); CEX(0, 2); CEX(1, 3); CEX(1, 2);
#undef CEX
                float wsum = 0.f; int myidx = 0; float myscore = 0.f;
#pragma unroll
                for (int k = 0; k < 8; ++k) {
                    const float mx = wave_max_dpp(h[0]);
                    const unsigned long long bal = __ballot(h[0] == mx);
                    const int own = (int)__builtin_ctzll(bal);
                    const int ei = __builtin_amdgcn_readlane(hi_[0], own);
                    const float sv = __builtin_bit_cast(float, __builtin_amdgcn_readlane(__builtin_bit_cast(int, hs[0]), own));
                    if (lane == own) { h[0] = h[1]; hi_[0] = hi_[1]; hs[0] = hs[1]; h[1] = h[2]; hi_[1] = hi_[2]; hs[1] = hs[2]; h[2] = h[3]; hi_[2] = hi_[3]; hs[2] = hs[3]; h[3] = -3e30f; }
                    wsum += sv;
                    if (lane == k) { myidx = ei; myscore = sv; }
                }
                if (lane < 8) {
                    EIDX[t * 8 + lane] = myidx; GATE[t * 8 + lane] = myscore / wsum * 2.5f;
                    POS[t * 8 + lane] = __hip_atomic_fetch_add(hist + myidx, 1, __ATOMIC_RELAXED, __HIP_MEMORY_SCOPE_WORKGROUP);
                }
            }
            __syncthreads();
            if (tid < 256) BH[vcu * 256 + tid] = hist[tid];
        } else if (ph == 14 && PH_EN(14)) {
            LAS int* tot = (LAS int*)(lds + TAB_OFF); LAS int* myb = tot + 256; LAS int* SBt = tot + 512;
            const int* BH = (const int*)(ws + WS_BH);
            __syncthreads();
            if (tid < 256) {
                int total = 0, mine = 0;
#pragma unroll 16
                for (int b2 = 0; b2 < G; ++b2) { const int v = ld_agent(BH + b2 * 256 + tid); total += v; mine += (b2 < vcu) ? v : 0; }
                tot[tid] = total; myb[tid] = mine;
                if (bx == 0) counts[tid] = total;
            }
            __syncthreads();
            if (wave == 0) {
                int c[4]; int ss = 0;
#pragma unroll
                for (int i = 0; i < 4; ++i) { c[i] = tot[4 * lane + i]; ss += c[i]; }
                int xs = ss;
#pragma unroll
                for (int o = 1; o < 64; o <<= 1) { const int ys = __shfl_up(xs, o); if (lane >= o) xs += ys; }
                int es = xs - ss;
#pragma unroll
                for (int i = 0; i < 4; ++i) { SBt[4 * lane + i] = es; es += c[i]; }
            }
            __syncthreads();
            const int* EIDX = (const int*)(ws + WS_EIDX); const int* POS = (const int*)(ws + WS_POS); int* SLOT = (int*)(ws + WS_SLOT); int* TOK = (int*)(ws + WS_TOK);
            for (int t = gw; t < T; t += NGW) if (lane < 8) { const int i = t * 8 + lane, e = EIDX[i]; const int sl = SBt[e] + myb[e] + POS[i]; SLOT[i] = sl; TOK[sl] = t; }
        } else if (ph == 18 && PH_EN(18)) {
            float* P18DST = (PH == 19) ? (float*)(ws + WS_WD) : ap->out;
            const unsigned char* YR = (const unsigned char*)(ws + WS_YROWS); const int* SLOT = (const int*)(ws + WS_SLOT); const float* GATE = (const float*)(ws + WS_GATE);
            for (int m0 = gw; m0 < T; m0 += 2 * NGW) {
                const int m1 = m0 + NGW;
                f32x4 va[4], vb[4]; u32x4 wa[8], wb[8]; float ga[8], gb[8];
                const u32x4* xa = (const u32x4*)((const bf16_t*)(ws + WS_PRE3) + (size_t)m0 * D) + 2 * lane; const u32x4* xb = (const u32x4*)((const bf16_t*)(ws + WS_PRE3) + (size_t)m1 * D) + 2 * lane;
#pragma unroll
                for (int k = 0; k < 8; ++k) {
                    const int sa = SLOT[m0 * 8 + k], sb = SLOT[m1 * 8 + k]; ga[k] = GATE[m0 * 8 + k] * (1.f / 32.f); gb[k] = GATE[m1 * 8 + k] * (1.f / 32.f);
                    wa[k] = *(const u32x4*)(YR + (size_t)sa * 1024 + 16 * lane); wb[k] = *(const u32x4*)(YR + (size_t)sb * 1024 + 16 * lane);
                }
#pragma unroll
                for (int jx = 0; jx < 2; ++jx) { const u32x4 pa = xa[jx], pb = xb[jx];
                    va[2 * jx] = (f32x4){bflo(pa.x), bfhi(pa.x), bflo(pa.y), bfhi(pa.y)}; va[2 * jx + 1] = (f32x4){bflo(pa.z), bfhi(pa.z), bflo(pa.w), bfhi(pa.w)};
                    vb[2 * jx] = (f32x4){bflo(pb.x), bfhi(pb.x), bflo(pb.y), bfhi(pb.y)}; vb[2 * jx + 1] = (f32x4){bflo(pb.z), bfhi(pb.z), bflo(pb.w), bfhi(pb.w)}; }
#pragma unroll
                for (int k = 0; k < 8; ++k)
#pragma unroll
                    for (int jx = 0; jx < 4; ++jx) {
                        { const int ww = (int)wa[k][jx]; const f32x2 lo = __builtin_amdgcn_cvt_pk_f32_fp8(ww, false), hi = __builtin_amdgcn_cvt_pk_f32_fp8(ww, true);
                          va[jx][0] += ga[k] * lo.x; va[jx][1] += ga[k] * lo.y; va[jx][2] += ga[k] * hi.x; va[jx][3] += ga[k] * hi.y; }
                        { const int ww = (int)wb[k][jx]; const f32x2 lo = __builtin_amdgcn_cvt_pk_f32_fp8(ww, false), hi = __builtin_amdgcn_cvt_pk_f32_fp8(ww, true);
                          vb[jx][0] += gb[k] * lo.x; vb[jx][1] += gb[k] * lo.y; vb[jx][2] += gb[k] * hi.x; vb[jx][3] += gb[k] * hi.y; }
                    }
                ln_store<false, true>(va, ap->in[30], ap->in[31], P18DST + (size_t)m0 * D, lane);
                ln_store<false, true>(vb, ap->in[30], ap->in[31], P18DST + (size_t)m1 * D, lane);
            }
        }
    }
}

__global__ void __launch_bounds__(512, 2) fwd(Args a_in) {
    extern __shared__ __attribute__((aligned(16))) unsigned char lds_raw[];
    LAS unsigned char* lds = (LAS unsigned char*)lds_raw;
    cg::grid_group grid = cg::this_grid();
    const int G = gridDim.x, bx = blockIdx.x;
    const int vcu = (G % 8 == 0) ? (bx % 8) * (G / 8) + bx / 8 : bx;
    const int ph_lo = a_in.ph_lo, ph_hi = a_in.ph_hi;
    volatile LAS unsigned* xst = (volatile LAS unsigned*)(lds + LDS_BYTES - 64);
    const int wv = __builtin_amdgcn_readfirstlane((int)threadIdx.x >> 6);
    { const int t0 = wv * 64 + lane_id(); if (t0 < 16) xst[t0] = 0u; }
    __syncthreads();
    const XcdBarrier xb = xcd_barrier_post((unsigned*)(a_in.ws + WS_CTL) + CW_BAR, xst, wv);
#ifndef REPMASK
#define REPMASK 0u
#endif
#define RUN(k) do { if (ph_lo <= (k) && (k) < ph_hi) { run_phase<k>(lds, a_in, G, bx, vcu, wv); if ((REPMASK >> (k)) & 1u) { xcd_barrier(xb, wv); run_phase<k>(lds, a_in, G, bx, vcu, wv); } } if (ph_lo <= (k) && (k) + 1 < ph_hi) { if ((k) == 0) grid.sync(); else xcd_barrier(xb, wv); } } while (0)
    RUN(0); RUN(1); RUN(2); RUN(3); RUN(4); RUN(5); RUN(6); RUN(7); RUN(8); RUN(9); RUN(10); RUN(11); RUN(12); RUN(13); RUN(14); RUN(15); RUN(17);
#ifdef PROBE18
    run_phase<19>(lds, a_in, G, bx, vcu, wv); xcd_barrier(xb, wv);
#endif
#ifdef PROBE17
    run_phase<21>(lds, a_in, G, bx, vcu, wv); xcd_barrier(xb, wv);
#endif
#ifdef PROBE13
    run_phase<20>(lds, a_in, G, bx, vcu, wv); xcd_barrier(xb, wv);
#endif
    RUN(18);
#undef RUN
}

extern "C" void kernel_launch(void* const* d_in, const int* in_sizes, int n_in, void* d_out, int out_size, void* d_ws, size_t ws_size, hipStream_t stream) {
    static int grid = 0;
    if (grid == 0) {
        if (n_in != 32 || out_size != T * D || ws_size < WS_END) { fprintf(stderr, "kernel_launch: unexpected shapes: n_in %d out %d ws %zu (need %zu)\n", n_in, out_size, ws_size, (size_t)WS_END); grid = -1; return; }
        int dev = 0, cus = 0, per_cu = 0;
        (void)hipGetDevice(&dev);
        (void)hipDeviceGetAttribute(&cus, hipDeviceAttributeMultiprocessorCount, dev);
        (void)hipFuncSetAttribute((const void*)fwd, hipFuncAttributeMaxDynamicSharedMemorySize, LDS_BYTES);
        (void)hipOccupancyMaxActiveBlocksPerMultiprocessor(&per_cu, (const void*)fwd, 512, LDS_BYTES);
        grid = cus;
        fprintf(stderr, "kernel_launch: grid %d (cus %d, occupancy query %d) ws %zu\n", grid, cus, per_cu, ws_size);
        if (per_cu < 1 || grid != 256) { fprintf(stderr, "kernel_launch: unsupported device geometry\n"); }
    }
    if (grid < 0) return;
    (void)hipMemsetAsync((char*)d_ws + WS_CTL, 0, CTL_BYTES, stream);
    Args a{};
    for (int i = 0; i < 32; ++i) a.in[i] = (const float*)d_in[i];
    a.out = (float*)d_out; a.ws = (unsigned char*)d_ws; a.ph_lo = 0; a.ph_hi = 19;
    void* args[] = {&a};
    hipError_t e = hipLaunchCooperativeKernel((const void*)fwd, dim3(grid), dim3(512), args, LDS_BYTES, stream);
    if (e != hipSuccess) fprintf(stderr, "kernel_launch: cooperative launch failed: %s\n", hipGetErrorString(e));
}
```
